# Optimizing an MI355X kernel written in HIP

```python
import jax, jax.numpy as jnp
from jax import lax
import numpy as np

D_MODEL = 1024
BATCH = 2
SEQ = 8192
DEPTH = 1

D_MIX = D_MODEL
ATTN_WIDTH = D_MIX // 2
ATTN_HEAD_DIM = 64
ATTN_HEADS = ATTN_WIDTH // ATTN_HEAD_DIM
DILATED_PATTERNS = ((128, 1), (512, 4), (2048, 16))
ATTN_BLOCK = 128
REL_BUCKETS = 32
REL_MAX_DIST = 2048
GLA_WIDTH = D_MIX - ATTN_WIDTH
GLA_DV = 128
GLA_HEADS = GLA_WIDTH // GLA_DV
GLA_DK = GLA_DV // 2
GLA_GATE_RANK = 16
GLA_GATE_NORMALIZER = 16.0
GLA_CHUNK = 64
PEER_HEADS = 8
PEER_NKEYS = 128
PEER_EXPERTS = PEER_NKEYS * PEER_NKEYS
PEER_QUERY_DIM = 256
PEER_TOPK = 16
PEER_TOKEN_BLOCK = 128
EPS = 1e-6
IN_SPLITS = (ATTN_WIDTH, ATTN_WIDTH, ATTN_WIDTH, GLA_HEADS * GLA_DK, GLA_HEADS * GLA_DK, GLA_WIDTH, GLA_WIDTH, GLA_GATE_RANK)
D_IN = sum(IN_SPLITS)

kernel_name = 'hybrid_dilated_gla_peer_block'


def rmsnorm(x, g):
    xf = x.astype(jnp.float32)
    y = xf * lax.rsqrt(jnp.mean(xf * xf, axis=-1, keepdims=True) + EPS)
    return (y * g.astype(jnp.float32)).astype(x.dtype)


def modulate(x, g, shift, scale):
    return rmsnorm(x, g) * (1 + scale[:, None, :]) + shift[:, None, :]


def t5_bucket(dist):
    max_exact = REL_BUCKETS // 2
    large = max_exact + (np.log(np.maximum(dist, 1) / max_exact) / np.log(REL_MAX_DIST / max_exact) * (REL_BUCKETS - max_exact)).astype(np.int64)
    large = np.minimum(large, REL_BUCKETS - 1)
    return np.where(dist < max_exact, dist, large).astype(np.int32)


def dilated_branch(q, k, v, rel_bias_table, window, dilation):
    B, S, H, Dh = q.shape
    blk = ATTN_BLOCK
    seg = dilation * blk
    s_pad = -(-S // seg) * seg
    L = s_pad // dilation
    nb = L // blk
    w_sub = window // dilation

    def to_sub(t):
        t = jnp.pad(t.astype(jnp.float32), ((0, 0), (0, s_pad - S), (0, 0), (0, 0)))
        return t.reshape(B, L, dilation, H, Dh).transpose(0, 2, 3, 1, 4)

    def band(t):
        cur = t.reshape(B, dilation, H, nb, blk, Dh)
        prev = jnp.concatenate([jnp.zeros_like(cur[:, :, :, :1]), cur[:, :, :, :-1]], axis=3)
        return jnp.concatenate([prev, cur], axis=4)

    qb = to_sub(q).reshape(B, dilation, H, nb, blk, Dh)
    kb = band(to_sub(k))
    vb = band(to_sub(v))
    qi = np.arange(blk)[:, None]
    kj = np.arange(2 * blk)[None, :]
    rel = qi + blk - kj
    in_window = (rel >= 0) & (rel <= w_sub)
    kpos = np.arange(nb)[:, None, None] * blk - blk + kj[None]
    mask = jnp.asarray(in_window[None] & (kpos >= 0))
    bucket = t5_bucket(np.maximum(rel, 0) * dilation)
    bias = jnp.transpose(rel_bias_table.astype(jnp.float32)[jnp.asarray(bucket)], (2, 0, 1))
    s = jnp.einsum('bdhnqe,bdhnke->bdhnqk', qb, kb) * (Dh ** -0.5) + bias[None, None, :, None]
    s = jnp.where(mask[None, None, None], s, -jnp.inf)
    m = jnp.max(s, axis=-1, keepdims=True)
    p = jnp.exp(s - m)
    den = jnp.sum(p, axis=-1, keepdims=True)
    o = jnp.einsum('bdhnqk,bdhnke->bdhnqe', p, vb) / den
    lse = (m + jnp.log(den))[..., 0]
    o = o.reshape(B, dilation, H, L, Dh).transpose(0, 3, 1, 2, 4).reshape(B, s_pad, H, Dh)[:, :S]
    lse = lse.reshape(B, dilation, H, L).transpose(0, 3, 1, 2).reshape(B, s_pad, H)[:, :S]
    return o, lse


def dilated_attention(q, k, v, rel_bias_table):
    outs, lses = [], []
    for window, dilation in DILATED_PATTERNS:
        o, lse = dilated_branch(q, k, v, rel_bias_table, window, dilation)
        outs.append(o)
        lses.append(lse)
    w = jax.nn.softmax(jnp.stack(lses), axis=0)
    return jnp.sum(w[..., None] * jnp.stack(outs), axis=0)


def gla_chunked(q, k, v, log_a):
    B, S, H, dk = q.shape
    dv = v.shape[-1]
    C = GLA_CHUNK
    nc = S // C

    def to_chunks(t):
        return t.reshape(B, nc, C, H, t.shape[-1]).transpose(1, 0, 3, 2, 4)

    causal = jnp.tril(jnp.ones((C, C), dtype=bool))

    def step(state, inp):
        qc, kc, vc, gc = inp
        b = jnp.cumsum(gc, axis=2)
        o_inter = jnp.einsum('bhcd,bhde->bhce', qc * jnp.exp(b), state)
        diff = b[:, :, :, None, :] - b[:, :, None, :, :]
        decay = jnp.exp(jnp.where(causal[:, :, None], diff, -jnp.inf))
        A = jnp.einsum('bhid,bhjd,bhijd->bhij', qc, kc, decay)
        o = o_inter + jnp.einsum('bhij,bhje->bhie', A, vc)
        b_last = b[:, :, -1:, :]
        state = state * jnp.exp(b_last[:, :, 0, :, None]) + jnp.einsum('bhjd,bhje->bhde', kc * jnp.exp(b_last - b), vc)
        return state, o

    state0 = jnp.zeros((B, H, dk, dv), jnp.float32)
    _, o = lax.scan(step, state0, (to_chunks(q), to_chunks(k), to_chunks(v), to_chunks(log_a)))
    return o.transpose(1, 0, 3, 2, 4).reshape(B, S, H, dv)


def token_mixer(h, w_in, w_gate2, b_gate, g_gla_norm, rel_bias_table, w_out):
    B, S, _ = h.shape
    proj = h @ w_in
    aq, ak, av, gq, gk, gv, gr, glr = jnp.split(proj, np.cumsum(IN_SPLITS)[:-1].tolist(), axis=-1)
    hd = (B, S, ATTN_HEADS, ATTN_HEAD_DIM)
    attn = dilated_attention(aq.reshape(hd), ak.reshape(hd), av.reshape(hd), rel_bias_table)
    attn = attn.reshape(B, S, ATTN_WIDTH).astype(h.dtype)
    f32 = jnp.float32
    gq = gq.reshape(B, S, GLA_HEADS, GLA_DK).astype(f32) * (GLA_DK ** -0.5)
    gk = gk.reshape(B, S, GLA_HEADS, GLA_DK).astype(f32)
    gv = gv.reshape(B, S, GLA_HEADS, GLA_DV).astype(f32)
    gate_logits = (glr @ w_gate2 + b_gate).astype(f32)
    log_a = (jax.nn.log_sigmoid(gate_logits) / GLA_GATE_NORMALIZER).reshape(B, S, GLA_HEADS, GLA_DK)
    o = gla_chunked(gq, gk, gv, log_a)
    o = o * lax.rsqrt(jnp.mean(o * o, axis=-1, keepdims=True) + EPS) * g_gla_norm.astype(f32)
    o = o * jax.nn.silu(gr.reshape(B, S, GLA_HEADS, GLA_DV).astype(f32))
    gla = o.reshape(B, S, GLA_WIDTH).astype(h.dtype)
    return jnp.concatenate([attn, gla], axis=-1) @ w_out


def peer_ffn(h, w_q, sub_keys, u_table, v_table):
    B, S, D = h.shape
    T = B * S
    hf = h.reshape(T, D)
    q = (hf @ w_q).reshape(T, PEER_HEADS, 2, PEER_QUERY_DIM // 2)
    s = jnp.einsum('thpd,hpkd->thpk', q, sub_keys).astype(jnp.float32)
    sv, si = lax.top_k(s, PEER_TOPK)
    nc = PEER_TOPK * PEER_TOPK
    cand = (sv[:, :, 0, :, None] + sv[:, :, 1, None, :]).reshape(T, PEER_HEADS, nc)
    cidx = (si[:, :, 0, :, None] * PEER_NKEYS + si[:, :, 1, None, :]).reshape(T, PEER_HEADS, nc)
    fv, fpos = lax.top_k(cand, PEER_TOPK)
    experts = jnp.take_along_axis(cidx, fpos, axis=-1).reshape(T, PEER_HEADS * PEER_TOPK)
    gates = jax.nn.softmax(fv, axis=-1).reshape(T, PEER_HEADS * PEER_TOPK).astype(h.dtype)
    nblk = T // PEER_TOKEN_BLOCK

    def block(args):
        xt, e, g = args
        a = jax.nn.gelu(jnp.einsum('tkd,td->tk', u_table[e], xt), approximate=False)
        return jnp.einsum('tk,tkd->td', g * a, v_table[e])

    out = lax.map(block, (hf.reshape(nblk, PEER_TOKEN_BLOCK, D),
                          experts.reshape(nblk, PEER_TOKEN_BLOCK, -1),
                          gates.reshape(nblk, PEER_TOKEN_BLOCK, -1)))
    return out.reshape(B, S, D)


def setup_inputs(seed: int = 0) -> dict:
    key = jax.random.key(seed)
    ks = jax.random.split(key, 20)
    L, D = DEPTH, D_MODEL
    nrm = jax.random.normal
    return {
        'x': nrm(ks[0], (BATCH, SEQ, D), jnp.float32),
        'c': nrm(ks[1], (BATCH, D), jnp.float32),
        'w_ada': nrm(ks[2], (L, D, 6 * D), jnp.float32) * (0.5 * D ** -0.5),
        'b_ada': nrm(ks[3], (L, 6 * D), jnp.float32) * 0.02,
        'g_pre_mix': 1.0 + 0.02 * nrm(ks[4], (L, D), jnp.float32),
        'g_post_mix': 1.0 + 0.02 * nrm(ks[5], (L, D), jnp.float32),
        'w_in': nrm(ks[6], (L, D, D_IN), jnp.float32) * D ** -0.5,
        'w_gate2': nrm(ks[7], (L, GLA_GATE_RANK, GLA_HEADS * GLA_DK), jnp.float32) * GLA_GATE_RANK ** -0.5,
        'b_gate': nrm(ks[8], (L, GLA_HEADS * GLA_DK), jnp.float32) * 0.1,
        'g_gla_norm': 1.0 + 0.02 * nrm(ks[9], (L, GLA_DV), jnp.float32),
        'rel_bias_table': nrm(ks[10], (REL_BUCKETS, ATTN_HEADS), jnp.float32) * 0.5,
        'w_out': nrm(ks[11], (L, D_MIX, D), jnp.float32) * D_MIX ** -0.5,
        'g_pre_ffn': 1.0 + 0.02 * nrm(ks[12], (L, D), jnp.float32),
        'g_post_ffn': 1.0 + 0.02 * nrm(ks[13], (L, D), jnp.float32),
        'w_peer_q': nrm(ks[14], (L, D, PEER_HEADS * PEER_QUERY_DIM), jnp.float32) * D ** -0.5,
        'peer_sub_keys': nrm(ks[15], (L, PEER_HEADS, 2, PEER_NKEYS, PEER_QUERY_DIM // 2), jnp.float32) * (PEER_QUERY_DIM // 2) ** -0.5,
        'peer_u': nrm(ks[16], (L, PEER_EXPERTS, D), jnp.float32) * D ** -0.5,
        'peer_v': nrm(ks[17], (L, PEER_EXPERTS, D), jnp.float32) * D ** -0.5,
    }


def reference(x, c, w_ada, b_ada, g_pre_mix, g_post_mix, w_in, w_gate2, b_gate, g_gla_norm,
              rel_bias_table, w_out, g_pre_ffn, g_post_ffn, w_peer_q, peer_sub_keys, peer_u, peer_v):
    for l in range(DEPTH):
        mod = jax.nn.silu(c) @ w_ada[l] + b_ada[l]
        sh1, sc1, ga1, sh2, sc2, ga2 = jnp.split(mod, 6, axis=-1)
        h = modulate(x, g_pre_mix[l], sh1, sc1)
        y = token_mixer(h, w_in[l], w_gate2[l], b_gate[l], g_gla_norm[l], rel_bias_table, w_out[l])
        x = x + ga1[:, None, :] * rmsnorm(y, g_post_mix[l])
        h = modulate(x, g_pre_ffn[l], sh2, sc2)
        y = peer_ffn(h, w_peer_q[l], peer_sub_keys[l], peer_u[l], peer_v[l])
        x = x + ga2[:, None, :] * rmsnorm(y, g_post_ffn[l])
    return x
```

```cpp
#include <hip/hip_runtime.h>
#include <cstdio>
#include <cstdint>
namespace pg8 {
#define PG8_LAS __attribute__((address_space(3)))
typedef unsigned short bf16_t;
typedef short bf16x8 __attribute__((ext_vector_type(8)));
typedef float f32x4 __attribute__((ext_vector_type(4)));
typedef unsigned u32x4 __attribute__((ext_vector_type(4)));
constexpr int BM = 256, BK = 64, HALF = 128, HTB = HALF * BK * 2  , STAGE_BYTES = 8 * HTB, NXCD = 8, WGM = 8;

__host__ __device__ __forceinline__ int lds_byte(int r, int c) { const int st = (r >> 4) * 2 + (c >> 5), rr = r & 15, cc = c & 31, ob = rr * 64 + cc * 2; return st * 1024 + (ob ^ (((ob >> 9) & 1) << 5)); }
__host__ __device__ __forceinline__ void stage_rc(int b, int& R, int& C) { const int st = b / 1024, sb = b % 1024, swz = sb ^ (((sb >> 9) & 1) << 5); R = (st >> 1) * 16 + swz / 64; C = (st & 1) * 32 + (swz % 64) / 2; }
__host__ __device__ __forceinline__ int perm32(int rho) { const int n = rho >> 4, i = rho & 15; return 8 * (i >> 2) + 4 * n + (i & 3); }

struct Unit { int pm, pn; };
struct Gemm { const bf16_t* A; const bf16_t* Bt; int M, N, K; };

struct StaticOrder {
    int nM, nN, nwg, G, c;
    __host__ __device__ void init(int M, int N, int G_, int c_) { nM = M / BM; nN = N / BM; nwg = nM * nN; G = G_; c = c_; }
    __host__ __device__ bool next(int i, Unit& u) const {
        const long L = (long)i * G + c; if (L >= nwg) return false;
        int wgid = (int)L; { const int q = nwg / NXCD, r = nwg % NXCD, xcd = wgid % NXCD, off = wgid / NXCD; wgid = (xcd < r ? xcd * (q + 1) : r * (q + 1) + (xcd - r) * q) + off; }
        const int nig = WGM * nN, gid = wgid / nig, fm = gid * WGM, gsz = (nM - fm) < WGM ? (nM - fm) : WGM;
        u.pm = fm + ((wgid % nig) % gsz); u.pn = (wgid % nig) / gsz; return true;
    }
    __device__ __forceinline__ void a_ready(const Unit&) const {}
    __device__ __forceinline__ void done(const Unit&) const {}
};

__device__ __forceinline__ unsigned cvt_pk_bf16(float lo, float hi) { unsigned r; asm volatile("v_cvt_pk_bf16_f32 %0, %1, %2" : "=v"(r) : "v"(lo), "v"(hi)); return r; }
typedef float f32x2 __attribute__((ext_vector_type(2)));
__device__ __forceinline__ f32x2 gelu_pk(f32x2 v) {
    const f32x2 av = __builtin_elementwise_abs(v), d = av * 0.2316418882f + 1.0f;
    f32x2 t; t.x = __builtin_amdgcn_rcpf(d.x); t.y = __builtin_amdgcn_rcpf(d.y);
    f32x2 q = t * 0.5307027145f + (-0.7265760135f); q = q * t + 0.7107068705f; q = q * t + (-0.142248368f); q = q * t + 0.127414796f; q = q * t;
    const f32x2 s = (v * v) * (-0.72134752044f);
    f32x2 e; e.x = __builtin_amdgcn_exp2f(s.x); e.y = __builtin_amdgcn_exp2f(s.y);
    const f32x2 m = v * (q * e), r = v - m;
    f32x2 o; o.x = v.x < 0.f ? m.x : r.x; o.y = v.y < 0.f ? m.y : r.y; return o;
}

template <int ACT  > struct EpiBf16 {
    static constexpr bool PERM = true, AFTER_DRAIN = false; static_assert(ACT == 0 || ACT == 1, "EpiBf16: ACT is 0 (none) or 1 (gelu_pk)");
    bf16_t* O; int ldc; const float* bias; int split_cols; size_t split_stride; float scale0;
    __device__ __forceinline__ void operator()(const f32x4 (&acc)[2][2][4][2], const Unit& u, int wr, int wc, int fr, int fq) const {
        const int row0 = u.pm * BM + wr * 64 + fr; int colt = u.pn * BM; bf16_t* base = O;
        float sc = 1.f; if (split_cols) { const int t = colt / split_cols; base += (size_t)t * split_stride; colt -= t * split_cols; if (t == 0) sc = scale0; }
        const int col0 = colt + wc * 32 + 8 * fq, bcol0 = u.pn * BM + wc * 32 + 8 * fq;
        f32x4 bv[2][2];
#pragma unroll
        for (int bj = 0; bj < 2; ++bj)
#pragma unroll
            for (int n = 0; n < 2; ++n) bv[bj][n] = bias ? *(const f32x4*)(bias + bcol0 + bj * HALF + 4 * n) : (f32x4){0.f, 0.f, 0.f, 0.f};
#pragma unroll
        for (int ai = 0; ai < 2; ++ai)
#pragma unroll
            for (int m = 0; m < 4; ++m) { bf16_t* rowp = base + (size_t)(row0 + ai * HALF + m * 16) * ldc + col0;
#pragma unroll
                for (int bj = 0; bj < 2; ++bj) { f32x4 v0 = acc[ai][bj][m][0] + bv[bj][0], v1 = acc[ai][bj][m][1] + bv[bj][1];
                    if (ACT == 1) { f32x2 a = gelu_pk((f32x2){v0[0], v0[1]}), b = gelu_pk((f32x2){v0[2], v0[3]}), c = gelu_pk((f32x2){v1[0], v1[1]}), d = gelu_pk((f32x2){v1[2], v1[3]});
                        v0 = (f32x4){a.x, a.y, b.x, b.y}; v1 = (f32x4){c.x, c.y, d.x, d.y}; }
                    v0 = v0 * sc; v1 = v1 * sc; u32x4 w; w.x = cvt_pk_bf16(v0[0], v0[1]); w.y = cvt_pk_bf16(v0[2], v0[3]); w.z = cvt_pk_bf16(v1[0], v1[1]); w.w = cvt_pk_bf16(v1[2], v1[3]);
                    *(u32x4*)(rowp + bj * HALF) = w; } }
    }
};
struct EpiProj {
    static constexpr bool PERM = true, AFTER_DRAIN = false;
    bf16_t* O; int ldc; int mode; float s_aq, s_gq;
    __device__ __forceinline__ void operator()(const f32x4 (&acc)[2][2][4][2], const Unit& u, int wr, int wc, int fr, int fq) const {
        const int row0 = u.pm * BM + wr * 64 + fr; const int col0 = u.pn * BM + wc * 32 + 8 * fq;
        float sc = 1.f; if (mode == 0) sc = (u.pn < 2) ? s_aq : (u.pn == 6 ? s_gq : 1.f);
#pragma unroll
        for (int ai = 0; ai < 2; ++ai)
#pragma unroll
            for (int m = 0; m < 4; ++m) { bf16_t* rowp = O + (size_t)(row0 + ai * HALF + m * 16) * ldc + col0;
#pragma unroll
                for (int bj = 0; bj < 2; ++bj) { f32x4 v0 = acc[ai][bj][m][0] * sc, v1 = acc[ai][bj][m][1] * sc;
                    u32x4 w; w.x = cvt_pk_bf16(v0[0], v0[1]); w.y = cvt_pk_bf16(v0[2], v0[3]); w.z = cvt_pk_bf16(v1[0], v1[1]); w.w = cvt_pk_bf16(v1[2], v1[3]);
                    *(u32x4*)(rowp + bj * HALF) = w; } }
    }
};
struct EpiF32 {
    static constexpr bool PERM = false, AFTER_DRAIN = false;
    float* O; int ldc;
    __device__ __forceinline__ void operator()(const f32x4 (&acc)[2][2][4][2], const Unit& u, int wr, int wc, int fr, int fq) const {
        const int col0 = u.pn * BM + wc * 32 + 4 * fq;
#pragma unroll
        for (int ai = 0; ai < 2; ++ai)
#pragma unroll
            for (int m = 0; m < 4; ++m) { const size_t off = (size_t)(u.pm * BM + ai * HALF + wr * 64 + m * 16 + fr) * ldc + col0;
#pragma unroll
                for (int bj = 0; bj < 2; ++bj)
#pragma unroll
                    for (int n = 0; n < 2; ++n) *(f32x4*)(O + off + bj * HALF + n * 16) = acc[ai][bj][m][n]; }
    }
};
template <class Epi, class Sched, bool ALIGN_EPI = false, bool SP2 = false>
__device__ __forceinline__ void gemm_phase(PG8_LAS unsigned char* lds, const Gemm g, const Sched& S, const Epi& E) {
    const int tid = threadIdx.x, wid = __builtin_amdgcn_readfirstlane(tid >> 6), lane = tid & 63, wr = wid >> 2, wc = wid & 3, fr = lane & 15, fq = lane >> 4;
    const int K = g.K, nt = K / BK;
    unsigned voffA[2], voffB[2];
#pragma unroll
    for (int i = 0; i < 2; ++i) { int R, C; stage_rc(tid * 16 + i * 8192, R, C); const int Rb = Epi::PERM ? ((R & ~31) + perm32(R & 31)) : R;
        voffA[i] = (unsigned)(R * K + C) * 2u; voffB[i] = (unsigned)(Rb * K + C) * 2u; }
    const size_t kstep = (size_t)(BK * 2);
    const size_t hstep = (size_t)HALF * K * 2;
    const size_t tstep = 2 * hstep;
    const unsigned ldsw = (unsigned)wid * 1024u;
    const int aoff = lds_byte(wr * 64 + fr, fq * 8), boff = lds_byte(wc * 32 + fr, fq * 8);
#define PG8_SA(b, h) (((b) * 2 + (h)) * HTB)
#define PG8_SB(b, h) ((4 + (b) * 2 + (h)) * HTB)
#define PG8_STAGE(bufoff, gbase, voff) do { _Pragma("unroll") for (int _i = 0; _i < 2; ++_i) \
        __builtin_amdgcn_global_load_lds((const unsigned*)((const char*)(gbase) + (voff)[_i]), (PG8_LAS unsigned*)(lds + (bufoff) + ldsw + _i * 8192), 16, 0, 0); } while (0)
#define PG8_LDA(dst, b, h) do { _Pragma("unroll") for (int m = 0; m < 4; ++m) _Pragma("unroll") for (int k = 0; k < 2; ++k) dst[m][k] = *(const PG8_LAS bf16x8*)(lds + PG8_SA(b, h) + aoff + m * 2048 + k * 1024); } while (0)
#define PG8_LDB(dst, b, h) do { _Pragma("unroll") for (int n = 0; n < 2; ++n) _Pragma("unroll") for (int k = 0; k < 2; ++k) dst[n][k] = *(const PG8_LAS bf16x8*)(lds + PG8_SB(b, h) + boff + n * 2048 + k * 1024); } while (0)
#define PG8_MMA(ai, bj, At, Bt) do { __builtin_amdgcn_s_setprio(1); _Pragma("unroll") for (int m = 0; m < 4; ++m) _Pragma("unroll") for (int n = 0; n < 2; ++n) _Pragma("unroll") for (int k = 0; k < 2; ++k) \
        acc[ai][bj][m][n] = __builtin_amdgcn_mfma_f32_16x16x32_bf16(Bt[n][k], At[m][k], acc[ai][bj][m][n], 0, 0, 0); __builtin_amdgcn_s_setprio(0); } while (0)
#define PG8_WAIT_V(n) asm volatile("s_waitcnt vmcnt(" #n ")" ::: "memory")
#define PG8_WAIT_L(n) asm volatile("s_waitcnt lgkmcnt(" #n ")" ::: "memory")
#define PG8_BAR __builtin_amdgcn_s_barrier()
#define PG8_SCHED __builtin_amdgcn_sched_barrier(0)
    Unit cur, nxt; int ui = 0;
    if (!S.next(0, cur)) return;
    f32x4 acc[2][2][4][2];
#pragma unroll
    for (int a = 0; a < 2; ++a)
#pragma unroll
        for (int b = 0; b < 2; ++b)
#pragma unroll
            for (int m = 0; m < 4; ++m)
#pragma unroll
                for (int n = 0; n < 2; ++n) acc[a][b][m][n] = (f32x4){0.f, 0.f, 0.f, 0.f};
    bf16x8 At[4][2], B0[2][2], B1[2][2];
    const char* cA = (const char*)g.A + (size_t)cur.pm * tstep; const char* cB = (const char*)g.Bt + (size_t)cur.pn * tstep;
    S.a_ready(cur);
    if constexpr (SP2) {
        PG8_STAGE(PG8_SB(0, 0), cB, voffB); PG8_STAGE(PG8_SB(0, 1), cB + hstep, voffB); PG8_STAGE(PG8_SA(0, 0), cA, voffA); PG8_STAGE(PG8_SA(0, 1), cA + hstep, voffA);
        if (wr == 1) PG8_BAR;
        PG8_WAIT_V(2); PG8_BAR;
        PG8_STAGE(PG8_SB(1, 0), cB + kstep, voffB); PG8_STAGE(PG8_SA(1, 0), cA + kstep, voffA); PG8_STAGE(PG8_SB(1, 1), cB + hstep + kstep, voffB);
        PG8_WAIT_V(6); PG8_BAR;
    } else {
        PG8_STAGE(PG8_SB(0, 0), cB, voffB); PG8_STAGE(PG8_SA(0, 0), cA, voffA); PG8_STAGE(PG8_SB(0, 1), cB + hstep, voffB); PG8_STAGE(PG8_SA(0, 1), cA + hstep, voffA);
        if (wr == 1) PG8_BAR;
        PG8_WAIT_V(4); PG8_BAR;
        PG8_STAGE(PG8_SB(1, 0), cB + kstep, voffB); PG8_STAGE(PG8_SA(1, 0), cA + kstep, voffA); PG8_STAGE(PG8_SB(1, 1), cB + hstep + kstep, voffB);
        PG8_WAIT_V(6); PG8_BAR;
    }
    for (;;) {
        const bool has_next = S.next(ui + 1, nxt);
        const char* nA = has_next ? (const char*)g.A + (size_t)nxt.pm * tstep : cA; const char* nB = has_next ? (const char*)g.Bt + (size_t)nxt.pn * tstep : cB;
        for (int t = 0; t < nt; t += 2) {
            const bool last = (t == nt - 2);
            const char* a1 = cA + (size_t)(t + 1) * kstep;
            const char* a2 = last ? nA : cA + (size_t)(t + 2) * kstep; const char* b2 = last ? nB : cB + (size_t)(t + 2) * kstep;
            const char* a3 = a2 + kstep; const char* b3 = b2 + kstep;
            if (last && has_next) S.a_ready(nxt);
            if constexpr (SP2) {
            PG8_LDB(B0, 0, 0); PG8_LDB(B1, 0, 1); PG8_SCHED; PG8_LDA(At, 0, 0); PG8_STAGE(PG8_SA(1, 1), a1 + hstep, voffA);
            PG8_WAIT_V(8); PG8_WAIT_L(0); PG8_BAR; PG8_MMA(0, 0, At, B0); PG8_MMA(0, 1, At, B1); PG8_BAR; PG8_SCHED;
            PG8_LDA(At, 0, 1); PG8_STAGE(PG8_SB(0, 0), b2, voffB); PG8_STAGE(PG8_SB(0, 1), b2 + hstep, voffB); PG8_STAGE(PG8_SA(0, 0), a2, voffA);
            PG8_WAIT_V(8); PG8_WAIT_L(0); PG8_BAR; PG8_MMA(1, 0, At, B0); PG8_MMA(1, 1, At, B1); PG8_BAR; PG8_SCHED;
            PG8_LDB(B0, 1, 0); PG8_LDB(B1, 1, 1); PG8_SCHED; PG8_LDA(At, 1, 0); PG8_STAGE(PG8_SA(0, 1), a2 + hstep, voffA);
            PG8_WAIT_V(8); PG8_WAIT_L(0); PG8_BAR; PG8_MMA(0, 0, At, B0); PG8_MMA(0, 1, At, B1); PG8_BAR; PG8_SCHED;
            PG8_LDA(At, 1, 1); PG8_STAGE(PG8_SB(1, 0), b3, voffB); PG8_STAGE(PG8_SB(1, 1), b3 + hstep, voffB); PG8_STAGE(PG8_SA(1, 0), a3, voffA);
            PG8_WAIT_V(8); PG8_WAIT_L(0); PG8_BAR; PG8_MMA(1, 0, At, B0); PG8_MMA(1, 1, At, B1); PG8_BAR; PG8_SCHED;
            } else {
            PG8_LDB(B0, 0, 0); PG8_SCHED; PG8_LDA(At, 0, 0); PG8_STAGE(PG8_SA(1, 1), a1 + hstep, voffA);
            PG8_WAIT_L(8); PG8_BAR; PG8_WAIT_L(0); PG8_MMA(0, 0, At, B0); PG8_BAR; PG8_SCHED;
            PG8_LDB(B1, 0, 1); PG8_STAGE(PG8_SB(0, 0), b2, voffB);
            PG8_BAR; PG8_WAIT_L(0); PG8_MMA(0, 1, At, B1); PG8_BAR;
            PG8_LDA(At, 0, 1); PG8_STAGE(PG8_SA(0, 0), a2, voffA);
            PG8_BAR; PG8_WAIT_L(0); PG8_MMA(1, 0, At, B0); PG8_BAR; PG8_SCHED;
            PG8_STAGE(PG8_SB(0, 1), b2 + hstep, voffB);
            PG8_WAIT_V(6); PG8_BAR; PG8_MMA(1, 1, At, B1); PG8_BAR;
            PG8_LDB(B0, 1, 0); PG8_SCHED; PG8_LDA(At, 1, 0); PG8_STAGE(PG8_SA(0, 1), a2 + hstep, voffA);
            PG8_WAIT_L(8); PG8_BAR; PG8_WAIT_L(0); PG8_MMA(0, 0, At, B0); PG8_BAR; PG8_SCHED;
            PG8_LDB(B1, 1, 1); PG8_STAGE(PG8_SB(1, 0), b3, voffB);
            PG8_BAR; PG8_WAIT_L(0); PG8_MMA(0, 1, At, B1); PG8_BAR;
            PG8_LDA(At, 1, 1); PG8_STAGE(PG8_SA(1, 0), a3, voffA);
            PG8_BAR; PG8_WAIT_L(0); PG8_MMA(1, 0, At, B0); PG8_BAR; PG8_SCHED;
            PG8_STAGE(PG8_SB(1, 1), b3 + hstep, voffB);
            PG8_WAIT_V(6); PG8_BAR; PG8_MMA(1, 1, At, B1); PG8_BAR;
            }
        }
        if constexpr (ALIGN_EPI) { if (wr == 0) PG8_BAR; }
        if constexpr (!Epi::AFTER_DRAIN) { E(acc, cur, wr, wc, fr, fq); S.done(cur); }
        if (!has_next) break;
#pragma unroll
        for (int a = 0; a < 2; ++a)
#pragma unroll
            for (int b = 0; b < 2; ++b)
#pragma unroll
                for (int m = 0; m < 4; ++m)
#pragma unroll
                    for (int n = 0; n < 2; ++n) acc[a][b][m][n] = (f32x4){0.f, 0.f, 0.f, 0.f};
        cur = nxt; cA = nA; cB = nB; ++ui;
        if constexpr (ALIGN_EPI) { if (wr == 1) PG8_BAR; }
    }
    PG8_WAIT_V(0);
    if constexpr (!ALIGN_EPI) { if (wr == 0) PG8_BAR; }
    PG8_BAR;
    if constexpr (Epi::AFTER_DRAIN) { E.fused(acc, cur, wr, wc, fr, fq, lds, wid, lane); S.done(cur); }
#undef PG8_SA
#undef PG8_SB
#undef PG8_STAGE
#undef PG8_LDA
#undef PG8_LDB
#undef PG8_MMA
#undef PG8_WAIT_V
#undef PG8_WAIT_L
#undef PG8_BAR
#undef PG8_SCHED
}
}
#ifndef PG8_SP2
#define PG8_SP2 true
#endif
#ifndef PG8_ALIGN
#define PG8_ALIGN true
#endif

constexpr int NWAVES = 8;
#ifndef MK_N_LAUNCHES
#define MK_N_LAUNCHES 1
#endif
constexpr int NPHASES = 11;

constexpr int BATCH = 2, SEQ = 8192, DM = 1024, M = BATCH * SEQ;
constexpr int DIN = 3088, NPROJ = 3072;
constexpr int C_AQ = 0, C_AK = 512, C_AV = 1024, C_GQ = 1536, C_GK = 1792, C_GV = 2048, C_GR = 2560, C_GLR = 3072;
constexpr int NH = 8;
constexpr int GH = 4, GDK = 64, GDV = 128, NCHUNK = SEQ / 64;
constexpr int PQD = 2048, NEXP = 16384;
constexpr float EPS = 1e-6f;
constexpr float LOG2E = 1.4426950408889634f;
constexpr float C2 = 0.125f * LOG2E;

constexpr size_t MiB = 1u << 20;
constexpr size_t WS_CTL = 0, CTL_ZERO_BYTES = 1 * MiB;
constexpr size_t WS_WIN = 2 * MiB, WS_WOUT = 8 * MiB, WS_WPQ = 10 * MiB, WS_SUBK = 14 * MiB, WS_DEC = 15 * MiB;
constexpr size_t WS_U16 = 16 * MiB, WS_V16 = 48 * MiB;
constexpr size_t WS_XN = 80 * MiB;
constexpr size_t WS_PROJ = 112 * MiB;
constexpr size_t WS_EIDX = 176 * MiB, WS_GATE = 184 * MiB;
constexpr size_t WS_LOGA = 208 * MiB;
constexpr size_t WS_UT = 224 * MiB, WS_END = 256 * MiB;
constexpr int CW_TMO = 0, CW_BAR = 4096, CW_MOD = 65536;
constexpr int MOD_SH1 = 0, MOD_SC1 = 1024, MOD_GA1 = 2048, MOD_SH2 = 3072, MOD_SC2 = 4096, MOD_GA2 = 5120, MOD_LD = 6144;

constexpr int RING_OFF = 0, RING_BYTES = 131072;
constexpr int LDSCTL_OFF = RING_BYTES, MISC_OFF = LDSCTL_OFF + 320;
constexpr int LDS_BYTES = 147456;

#define GAS __attribute__((address_space(1)))
#define LAS __attribute__((address_space(3)))
typedef unsigned short bf16;
typedef unsigned v4u __attribute__((ext_vector_type(4)));
typedef unsigned v2u __attribute__((ext_vector_type(2)));
typedef float f32x4 __attribute__((ext_vector_type(4)));
typedef float f32x2 __attribute__((ext_vector_type(2)));
typedef short bf16x8 __attribute__((ext_vector_type(8)));
typedef short s16x4 __attribute__((ext_vector_type(4)));
typedef __bf16 bf16x2_t __attribute__((ext_vector_type(2)));
typedef GAS unsigned gu32;
#define RLX_AGENT __ATOMIC_RELAXED, __HIP_MEMORY_SCOPE_AGENT
#define LDS_WAIT() asm volatile("s_waitcnt lgkmcnt(0)" ::: "memory")
#define VM_WAIT() asm volatile("s_waitcnt vmcnt(0)" ::: "memory")
__device__ __forceinline__ unsigned f2bf(float f) { unsigned u = __builtin_bit_cast(unsigned, f); return (u + 0x7fffu + ((u >> 16) & 1u)) >> 16; }
__device__ __forceinline__ unsigned pk2(float lo, float hi) { f32x2 v = {lo, hi}; bf16x2_t b = __builtin_convertvector(v, bf16x2_t); return __builtin_bit_cast(unsigned, b); }
__device__ __forceinline__ float bflo(unsigned w) { return __builtin_bit_cast(float, w << 16); }
__device__ __forceinline__ float bfhi(unsigned w) { return __builtin_bit_cast(float, w & 0xffff0000u); }
__device__ __forceinline__ float dot2bf(unsigned a, unsigned b, float acc) { return __builtin_amdgcn_fdot2_f32_bf16(__builtin_bit_cast(bf16x2_t, a), __builtin_bit_cast(bf16x2_t, b), acc, false); }
__device__ __forceinline__ f32x4 mfma16(bf16x8 a, bf16x8 b, f32x4 c) { return __builtin_amdgcn_mfma_f32_16x16x32_bf16(a, b, c, 0, 0, 0); }
typedef short v4i16_t __attribute__((ext_vector_type(4)));
__device__ __forceinline__ s16x4 tr16(const LAS unsigned char* p) { return __builtin_bit_cast(s16x4, __builtin_amdgcn_ds_read_tr16_b64_v4i16((LAS v4i16_t*)p)); }
__device__ __forceinline__ bf16x8 cat8(s16x4 lo, s16x4 hi) { return (bf16x8){lo[0], lo[1], lo[2], lo[3], hi[0], hi[1], hi[2], hi[3]}; }
__device__ __forceinline__ bf16x8 pack8(f32x4 a, f32x4 b) { v4u w; w.x = pk2(a[0], a[1]); w.y = pk2(a[2], a[3]); w.z = pk2(b[0], b[1]); w.w = pk2(b[2], b[3]); return __builtin_bit_cast(bf16x8, w); }
__device__ __forceinline__ float wave_sum(float v) {
#pragma unroll
    for (int o = 1; o < 64; o <<= 1) v += __shfl_xor(v, o);
    return v;
}

#define XB_TMO      128
#define XB_XCNT(j)  (256  + 64 * (j))
#define XB_XSUB(j)  (1280 + 64 * (j))
#define XB_XGEN(j)  (2304 + 64 * (j))
#define XB_TOP      3328
#define XB_TOPGEN   3392
#define XCD_BAR_WORDS 3456
#define XB_SPIN_CAP (1u << 18)
__device__ __forceinline__ unsigned xb_ld(unsigned* p)              { return __hip_atomic_load(p, __ATOMIC_RELAXED, __HIP_MEMORY_SCOPE_AGENT); }
__device__ __forceinline__ unsigned xb_add(unsigned* p, unsigned v) { return __hip_atomic_fetch_add(p, v, __ATOMIC_RELAXED, __HIP_MEMORY_SCOPE_AGENT); }
__device__ __forceinline__ unsigned xb_xcc_id() { return (unsigned)__builtin_amdgcn_s_getreg((3 << 11) | 20) & 0xFu; }
#define XB_SPIN(cond, bar) do { unsigned _sp = 0; while (cond) { __builtin_amdgcn_s_sleep(1); \
    if ((++_sp & 255u) == 0u) { if (xb_ld(&(bar)[XB_TMO])) break; if (_sp > XB_SPIN_CAP) { atomicAdd(&(bar)[XB_TMO], 1u); break; } } } } while (0)
struct XcdBarrier { unsigned* bar; unsigned x; volatile LAS unsigned* st; };
__device__ __forceinline__ XcdBarrier xcd_barrier_post(unsigned* bar, volatile LAS unsigned* st) {
    XcdBarrier b; b.bar = bar; b.x = xb_xcc_id(); b.st = st;
    if (threadIdx.x == 0) (void)xb_add(&bar[XB_XCNT(b.x)], 1u);
    return b;
}
__device__ __forceinline__ void xcd_barrier_complete(unsigned* bar, unsigned x, unsigned& nloc, unsigned& nx) {
    const unsigned G = gridDim.x * gridDim.y * gridDim.z;
    unsigned sum, cnt, mine, sp = 0u;
    for (;;) {
        sum = 0u; cnt = 0u; mine = 0u;
#pragma unroll
        for (unsigned j = 0; j < 16; ++j) { const unsigned c = xb_ld(&bar[XB_XCNT(j)]); sum += c; cnt += (c > 0u) ? 1u : 0u; mine = (j == x) ? c : mine; }
        if (sum == G) break;
        __builtin_amdgcn_s_sleep(1);
        if ((++sp & 255u) == 0u) { if (xb_ld(&bar[XB_TMO])) break; if (sp > XB_SPIN_CAP) { atomicAdd(&bar[XB_TMO], 1u); break; } }
    }
    nloc = mine > 0u ? mine : 1u; nx = cnt > 0u ? cnt : 1u;
}
__device__ __forceinline__ void xcd_barrier(const XcdBarrier& b) {
    asm volatile("s_waitcnt vmcnt(0)" ::: "memory");
    __syncthreads();
    if (threadIdx.x == 0) {
        unsigned* bar = b.bar;
        __builtin_amdgcn_s_waitcnt(0);
        unsigned nloc = b.st[0], nx = b.st[1];
        if (nloc == 0u) { xcd_barrier_complete(bar, b.x, nloc, nx); b.st[0] = nloc; b.st[1] = nx; }
        const unsigned old = xb_add(&bar[XB_XSUB(b.x)], 1u);
        const unsigned gen = old / nloc;
        if (old + 1u == (gen + 1u) * nloc) {
            __builtin_amdgcn_fence(__ATOMIC_RELEASE, "agent");
            asm volatile("s_waitcnt vmcnt(0)" ::: "memory");
            const unsigned og = xb_add(&bar[XB_TOP], 1u);
            const unsigned tg = og / nx;
            if (og + 1u == (tg + 1u) * nx) xb_add(&bar[XB_TOPGEN], 1u);
            else XB_SPIN(xb_ld(&bar[XB_TOPGEN]) == tg, bar);
            __builtin_amdgcn_fence(__ATOMIC_ACQUIRE, "agent");
            xb_add(&bar[XB_XGEN(b.x)], 1u);
            asm volatile("s_waitcnt vmcnt(0)" ::: "memory");
        } else {
            XB_SPIN(xb_ld(&bar[XB_XGEN(b.x)]) == gen, bar);
            __builtin_amdgcn_fence(__ATOMIC_ACQUIRE, "agent");
            asm volatile("s_waitcnt vmcnt(0)" ::: "memory");
        }
    }
    __syncthreads();
}

struct Frame {
    LAS unsigned char* lds;
    volatile LAS unsigned* MISC;
    gu32* ctl;
    int tid, lane, wave;
    int vcu, G;
    const float *x, *c, *w_ada, *b_ada, *g_pre_mix, *g_post_mix, *w_in, *w_gate2, *b_gate, *g_gla, *rel_bias, *w_out, *g_pre_ffn, *g_post_ffn, *w_pq, *sub_keys, *peer_u, *peer_v;
    float* out;
    unsigned char* ws;
};
#define WSP(T, off) ((T*)(F.ws + (off)))

__device__ __forceinline__ void p0_transpose_item(const float* W, int ldw, int K, int nblk, bf16* WT, LAS float* scr, int item, int lane) {
    const int kb = item / nblk, nb = item % nblk, k0 = 64 * kb, n0 = 32 * nb;
#pragma unroll 8
    for (int i = 0; i < 32; ++i) { const int kk = 2 * i + (lane >> 5); scr[kk * 33 + (lane & 31)] = W[(size_t)(k0 + kk) * ldw + n0 + (lane & 31)]; }
    LDS_WAIT(); asm volatile("" ::: "memory");
    const int c = lane & 7;
#pragma unroll
    for (int j = 0; j < 4; ++j) { const int n = (lane >> 3) + 8 * j; const LAS float* s = scr + (8 * c) * 33 + n;
        v4u o; o.x = pk2(s[0 * 33], s[1 * 33]); o.y = pk2(s[2 * 33], s[3 * 33]); o.z = pk2(s[4 * 33], s[5 * 33]); o.w = pk2(s[6 * 33], s[7 * 33]);
        *(GAS v4u*)(WT + (size_t)(n0 + n) * K + k0 + 8 * c) = o; }
    LDS_WAIT(); asm volatile("" ::: "memory");
}
__device__ __forceinline__ void cvt_stream(const float* src, bf16* dst, size_t nvec8, int gw, int NGW, int lane) {
    for (size_t i = (size_t)gw * 64 + lane; i < nvec8; i += (size_t)NGW * 64) {
        const f32x4 a = *(const GAS f32x4*)(src + i * 8), b = *(const GAS f32x4*)(src + i * 8 + 4);
        v4u o; o.x = pk2(a[0], a[1]); o.y = pk2(a[2], a[3]); o.z = pk2(b[0], b[1]); o.w = pk2(b[2], b[3]);
        *(GAS v4u*)(dst + i * 8) = o; }
}
__device__ __forceinline__ void p0_prologue(Frame& F) {
    LAS float* scr = (LAS float*)(F.lds + RING_OFF + F.wave * 16384);
    const int gw = F.vcu * NWAVES + F.wave, NGW = F.G * NWAVES, lane = F.lane;
    float* MOD = (float*)(F.ctl + CW_MOD);
    for (int nb = F.vcu; nb < 96; nb += F.G) {
        const int n = nb * 64 + lane;
        float a0 = 0.f, a1 = 0.f;
#pragma unroll 8
        for (int kk = 0; kk < 128; ++kk) { const int k = F.wave * 128 + kk; const float w = F.w_ada[(size_t)k * 6144 + n];
            const float c0 = F.c[k], c1 = F.c[1024 + k];
            a0 += (c0 / (1.f + __expf(-c0))) * w; a1 += (c1 / (1.f + __expf(-c1))) * w; }
        LAS float* red = (LAS float*)(F.lds + RING_OFF + F.wave * 16384 + 12288);
        red[lane] = a0; red[64 + lane] = a1;
        __syncthreads();
        if (F.wave == 0) {
            float s0 = F.b_ada[n], s1 = s0;
#pragma unroll
            for (int w = 0; w < 8; ++w) { const LAS float* rw = (const LAS float*)(F.lds + RING_OFF + w * 16384 + 12288); s0 += rw[lane]; s1 += rw[64 + lane]; }
            MOD[n] = s0; MOD[MOD_LD + n] = s1;
        }
        __syncthreads();
    }
    constexpr int I_IN = 16 * 96, I_OUT = 16 * 32, I_PQ = 16 * 64;
    for (int it = gw; it < I_IN + I_OUT + I_PQ; it += NGW) {
        int r = it;
        if (r < I_IN) { p0_transpose_item(F.w_in, DIN, DM, 96, WSP(bf16, WS_WIN), scr, r, lane); continue; } r -= I_IN;
        if (r < I_OUT) { p0_transpose_item(F.w_out, DM, DM, 32, WSP(bf16, WS_WOUT), scr, r, lane); continue; } r -= I_OUT;
        p0_transpose_item(F.w_pq, PQD, DM, 64, WSP(bf16, WS_WPQ), scr, r, lane);
    }
    cvt_stream(F.sub_keys, WSP(bf16, WS_SUBK), (size_t)8 * 2 * 128 * 128 / 8, gw, NGW, lane);
    cvt_stream(F.peer_u, WSP(bf16, WS_U16), (size_t)NEXP * DM / 8, gw, NGW, lane);
    cvt_stream(F.peer_v, WSP(bf16, WS_V16), (size_t)NEXP * DM / 8, gw, NGW, lane);
}

constexpr int P1_WGL = 0, P1_WG2 = 81920, P1_BG = 98304;
__device__ __forceinline__ float log_sigmoid(float z) { return fminf(z, 0.f) - log1pf(__expf(-fabsf(z))); }
__device__ __forceinline__ void p1_modulate(Frame& F) {
    LAS float* WGL = (LAS float*)(F.lds + P1_WGL); LAS float* WG2 = (LAS float*)(F.lds + P1_WG2); LAS float* BG = (LAS float*)(F.lds + P1_BG);
    for (int idx = F.tid; idx < 1024 * 16; idx += NWAVES * 64) { const int k = idx >> 4, c = idx & 15; const int j = k >> 8, l = (k >> 2) & 63, e = k & 3;
        WGL[((j * 4 + e) * 64 + l) * 20 + c] = F.w_in[(size_t)k * DIN + C_GLR + c]; }
    for (int idx = F.tid; idx < 16 * 256; idx += NWAVES * 64) WG2[idx] = F.w_gate2[idx];
    for (int idx = F.tid; idx < 256; idx += NWAVES * 64) BG[idx] = F.b_gate[idx];
    __syncthreads();
    const int gw = F.vcu * NWAVES + F.wave, NGW = F.G * NWAVES, lane = F.lane;
    const float* MOD = (const float*)(F.ctl + CW_MOD);
    bf16* XN = WSP(bf16, WS_XN); float* LOGA = WSP(float, WS_LOGA);
    for (int m = gw; m < M; m += NGW) {
        const int b = m >> 13;
        const GAS f32x4* xr = (const GAS f32x4*)(F.x + (size_t)m * DM) + lane;
        f32x4 v[4]; float s = 0.f;
#pragma unroll
        for (int j = 0; j < 4; ++j) { v[j] = xr[64 * j]; s += (v[j].x * v[j].x + v[j].y * v[j].y) + (v[j].z * v[j].z + v[j].w * v[j].w); }
        const float rstd = 1.f / sqrtf(wave_sum(s) * (1.f / DM) + EPS);
        float part[16];
#pragma unroll
        for (int c = 0; c < 16; ++c) part[c] = 0.f;
        GAS v2u* o8 = (GAS v2u*)(XN + (size_t)m * DM) + lane;
#pragma unroll
        for (int j = 0; j < 4; ++j) {
            const f32x4 g = *(const GAS f32x4*)(F.g_pre_mix + 256 * j + 4 * lane);
            const f32x4 sc = *(const GAS f32x4*)(MOD + b * MOD_LD + MOD_SC1 + 256 * j + 4 * lane), sh = *(const GAS f32x4*)(MOD + b * MOD_LD + MOD_SH1 + 256 * j + 4 * lane);
            f32x4 h = v[j] * rstd * g * (sc + 1.f) + sh;
            v2u w; w.x = pk2(h.x, h.y); w.y = pk2(h.z, h.w); o8[64 * j] = w;
#pragma unroll
            for (int e = 0; e < 4; ++e) { const LAS float* wp = WGL + ((j * 4 + e) * 64 + lane) * 20; const float hv = h[e];
#pragma unroll
                for (int c4 = 0; c4 < 4; ++c4) { const f32x4 w4 = *(const LAS f32x4*)(wp + 4 * c4);
                    part[4 * c4 + 0] += hv * w4.x; part[4 * c4 + 1] += hv * w4.y; part[4 * c4 + 2] += hv * w4.z; part[4 * c4 + 3] += hv * w4.w; }
                asm volatile("" ::: "memory"); }
        }
#pragma unroll
        for (int c = 0; c < 16; ++c) part[c] = wave_sum(part[c]);
#pragma unroll
        for (int i = 0; i < 4; ++i) { const int n = lane + 64 * i; float z = BG[n];
#pragma unroll
            for (int c = 0; c < 16; ++c) z += part[c] * WG2[c * 256 + n];
            LOGA[(size_t)m * 256 + n] = log_sigmoid(z) * (1.f / 16.f); }
    }
}
constexpr int GL_HALF = 45056, GL_BC = 0, GL_K = 16384, GL_V = 25600, GL_TOT = 43008, GL_Q = 44032;
constexpr int GL_HALF5 = 53248;
constexpr int KP = 72, VP = 136;
__device__ __forceinline__ void gla_bcum(const float* LOGA, int b, int h, int c, LAS float* bc, LAS float* tot, int tl) {
    const int d = tl & 63, qt = tl >> 6;
    float loc[16]; float run = 0.f;
    const float* src = LOGA + ((size_t)(b * SEQ + c * 64 + qt * 16)) * 256 + h * 64 + d;
#pragma unroll
    for (int i = 0; i < 16; ++i) { run += src[(size_t)i * 256]; loc[i] = run; }
    tot[qt * 64 + d] = run;
    __syncthreads();
    float off = 0.f;
#pragma unroll
    for (int q = 0; q < 3; ++q) if (q < qt) off += tot[q * 64 + d];
#pragma unroll
    for (int i = 0; i < 16; ++i) bc[(qt * 16 + i) * 64 + d] = loc[i] + off;
    __syncthreads();
}
__device__ __forceinline__ void gla_prep_item(Frame& F, int item, LAS unsigned char* L, int tl, int wl, int lane) {
    const int bh = item >> 7, c = item & 127, b = bh >> 2, h = bh & 3;
    LAS float* bc = (LAS float*)(L + GL_BC); LAS float* tot = (LAS float*)(L + GL_TOT);
    LAS bf16* kh = (LAS bf16*)(L + GL_K); LAS bf16* vv = (LAS bf16*)(L + GL_V);
    const bf16* PROJ = WSP(bf16, WS_PROJ);
    gla_bcum(WSP(float, WS_LOGA), b, h, c, bc, tot, tl);
    const size_t row0 = (size_t)b * SEQ + c * 64;
#pragma unroll
    for (int rep = 0; rep < 2; ++rep) { const int p = tl + 256 * rep, i = p >> 3, o = p & 7;
        const v4u kw = *(const GAS v4u*)(PROJ + (row0 + i) * NPROJ + C_GK + h * 64 + 8 * o);
        float f[8];
#pragma unroll
        for (int e = 0; e < 4; ++e) { f[2 * e] = bflo(kw[e]); f[2 * e + 1] = bfhi(kw[e]); }
#pragma unroll
        for (int e = 0; e < 8; ++e) f[e] *= __expf(bc[63 * 64 + 8 * o + e] - bc[i * 64 + 8 * o + e]);
        v4u ow; ow.x = pk2(f[0], f[1]); ow.y = pk2(f[2], f[3]); ow.z = pk2(f[4], f[5]); ow.w = pk2(f[6], f[7]);
        *(LAS v4u*)(kh + i * KP + 8 * o) = ow; }
#pragma unroll
    for (int rep = 0; rep < 4; ++rep) { const int p = tl + 256 * rep, i = p >> 4, o = p & 15;
        *(LAS v4u*)(vv + i * VP + 8 * o) = *(const GAS v4u*)(PROJ + (row0 + i) * NPROJ + C_GV + h * 128 + 8 * o); }
    __syncthreads();
    const int i16 = lane & 15, g = lane >> 4;
    f32x4 acc[2][4];
#pragma unroll
    for (int a = 0; a < 2; ++a)
#pragma unroll
        for (int n = 0; n < 4; ++n) acc[a][n] = (f32x4){0.f, 0.f, 0.f, 0.f};
#pragma unroll
    for (int ks = 0; ks < 2; ++ks) {
        bf16x8 A[2], B[4];
        const int krow = 32 * ks + 8 * g + (i16 >> 2);
#pragma unroll
        for (int a = 0; a < 2; ++a) { const LAS unsigned char* p = (const LAS unsigned char*)(vv + krow * VP + 16 * (2 * wl + a) + 4 * (i16 & 3)); A[a] = cat8(tr16(p), tr16(p + 4 * VP * 2)); }
#pragma unroll
        for (int n = 0; n < 4; ++n) { const LAS unsigned char* p = (const LAS unsigned char*)(kh + krow * KP + 16 * n + 4 * (i16 & 3)); B[n] = cat8(tr16(p), tr16(p + 4 * KP * 2)); }
#pragma unroll
        for (int a = 0; a < 2; ++a)
#pragma unroll
            for (int n = 0; n < 4; ++n) acc[a][n] = mfma16(A[a], B[n], acc[a][n]);
    }
    float* UT = WSP(float, WS_UT) + (size_t)(bh * 128 + c) * 8192;
#pragma unroll
    for (int a = 0; a < 2; ++a)
#pragma unroll
        for (int n = 0; n < 4; ++n)
#pragma unroll
            for (int r = 0; r < 4; ++r) UT[(16 * (2 * wl + a) + 4 * g + r) * 64 + 16 * n + i16] = acc[a][n][r];
    if (tl < 64) WSP(float, WS_DEC)[(size_t)(bh * 128 + c) * 64 + tl] = __expf(bc[63 * 64 + tl]);
    __syncthreads();
}
__device__ __forceinline__ void gla_scan(Frame& F) {
    if (F.tid >= 256) return;
    float* UT = WSP(float, WS_UT); const float* DEC = WSP(float, WS_DEC);
    for (int blk = F.vcu; blk < 256; blk += F.G) {
        const int bh = blk >> 5, e = (blk & 31) * 4 + (F.tid >> 6), d = F.tid & 63;
        float* p = UT + (size_t)bh * 128 * 8192 + e * 64 + d; const float* dc = DEC + (size_t)bh * 128 * 64 + d;
        float S = 0.f;
        for (int c0 = 0; c0 < 128; c0 += 8) {
            float u[8], a[8];
#pragma unroll
            for (int j = 0; j < 8; ++j) { u[j] = p[(size_t)(c0 + j) * 8192]; a[j] = dc[(c0 + j) * 64]; }
#pragma unroll
            for (int j = 0; j < 8; ++j) { p[(size_t)(c0 + j) * 8192] = S; S = a[j] * S + u[j]; }
        }
    }
}
__device__ __forceinline__ void gla_out_item(Frame& F, int item, LAS unsigned char* L, int tl, int wl, int lane) {
    const int bh = item >> 7, c = item & 127, b = bh >> 2, h = bh & 3;
    LAS float* bc = (LAS float*)(L + GL_BC); LAS float* tot = (LAS float*)(L + GL_TOT);
    LAS bf16* kt = (LAS bf16*)(L + GL_K); LAS bf16* vv = (LAS bf16*)(L + GL_V); LAS bf16* qs = (LAS bf16*)(L + GL_Q);
    const bf16* PROJ = WSP(bf16, WS_PROJ);
    gla_bcum(WSP(float, WS_LOGA), b, h, c, bc, tot, tl);
    const size_t row0 = (size_t)b * SEQ + c * 64;
#pragma unroll
    for (int rep = 0; rep < 2; ++rep) { const int p = tl + 256 * rep, i = p >> 3, o = p & 7;
        const v4u kw = *(const GAS v4u*)(PROJ + (row0 + i) * NPROJ + C_GK + h * 64 + 8 * o);
        const v4u qw = *(const GAS v4u*)(PROJ + (row0 + i) * NPROJ + C_GQ + h * 64 + 8 * o);
        float fk[8], fq[8];
#pragma unroll
        for (int e = 0; e < 4; ++e) { fk[2 * e] = bflo(kw[e]); fk[2 * e + 1] = bfhi(kw[e]); fq[2 * e] = bflo(qw[e]); fq[2 * e + 1] = bfhi(qw[e]); }
#pragma unroll
        for (int e = 0; e < 8; ++e) { const float bb = bc[i * 64 + 8 * o + e]; fk[e] *= __expf(-bb); fq[e] *= __expf(bb); }
        v4u ow; ow.x = pk2(fk[0], fk[1]); ow.y = pk2(fk[2], fk[3]); ow.z = pk2(fk[4], fk[5]); ow.w = pk2(fk[6], fk[7]);
        *(LAS v4u*)(kt + i * KP + 8 * o) = ow;
        ow.x = pk2(fq[0], fq[1]); ow.y = pk2(fq[2], fq[3]); ow.z = pk2(fq[4], fq[5]); ow.w = pk2(fq[6], fq[7]);
        *(LAS v4u*)(qs + i * KP + 8 * o) = ow; }
#pragma unroll
    for (int rep = 0; rep < 4; ++rep) { const int p = tl + 256 * rep, i = p >> 4, o = p & 15;
        *(LAS v4u*)(vv + i * VP + 8 * o) = *(const GAS v4u*)(PROJ + (row0 + i) * NPROJ + C_GV + h * 128 + 8 * o); }
    __syncthreads();
    const int i16 = lane & 15, g = lane >> 4;
    const int itok = 16 * wl + i16;
    bf16x8 Bq[2];
#pragma unroll
    for (int ks = 0; ks < 2; ++ks) Bq[ks] = *(const LAS bf16x8*)(qs + itok * KP + 32 * ks + 8 * g);
    bf16x8 Pf[2];
#pragma unroll
    for (int jp = 0; jp < 2; ++jp) {
        const int ja = 32 * jp + 8 * (i16 >> 2) + (i16 & 3), jb = ja + 4;
        f32x4 sa = {0.f, 0.f, 0.f, 0.f}, sb = {0.f, 0.f, 0.f, 0.f};
#pragma unroll
        for (int ks = 0; ks < 2; ++ks) {
            const bf16x8 Aa = *(const LAS bf16x8*)(kt + ja * KP + 32 * ks + 8 * g), Ab = *(const LAS bf16x8*)(kt + jb * KP + 32 * ks + 8 * g);
            sa = mfma16(Aa, Bq[ks], sa); sb = mfma16(Ab, Bq[ks], sb); }
#pragma unroll
        for (int r = 0; r < 4; ++r) { const int j = 32 * jp + 8 * g + r; sa[r] = (j <= itok) ? sa[r] : 0.f; sb[r] = (j + 4 <= itok) ? sb[r] : 0.f; }
        Pf[jp] = pack8(sa, sb);
    }
    f32x4 acc[8];
    const float* ST = WSP(float, WS_UT) + (size_t)(bh * 128 + c) * 8192;
#pragma unroll
    for (int mt = 0; mt < 8; ++mt) {
        f32x4 a = {0.f, 0.f, 0.f, 0.f};
#pragma unroll
        for (int jp = 0; jp < 2; ++jp) { const LAS unsigned char* p = (const LAS unsigned char*)(vv + (32 * jp + 8 * g + (i16 >> 2)) * VP + 16 * mt + 4 * (i16 & 3));
            a = mfma16(cat8(tr16(p), tr16(p + 4 * VP * 2)), Pf[jp], a); }
#pragma unroll
        for (int ks = 0; ks < 2; ++ks) { const float* sp = ST + (16 * mt + i16) * 64 + 32 * ks + 8 * g;
            const f32x4 s0 = *(const GAS f32x4*)sp, s1 = *(const GAS f32x4*)(sp + 4);
            a = mfma16(pack8(s0, s1), Bq[ks], a); }
        acc[mt] = a;
    }
    float ss = 0.f;
#pragma unroll
    for (int mt = 0; mt < 8; ++mt) ss += (acc[mt][0] * acc[mt][0] + acc[mt][1] * acc[mt][1]) + (acc[mt][2] * acc[mt][2] + acc[mt][3] * acc[mt][3]);
    ss += __shfl_xor(ss, 16); ss += __shfl_xor(ss, 32);
    const float rstd = 1.f / sqrtf(ss * (1.f / 128.f) + EPS);
    const size_t trow = row0 + itok;
    bf16* MIX = WSP(bf16, WS_XN);
#pragma unroll
    for (int mt = 0; mt < 8; ++mt) { const int e0 = 16 * mt + 4 * g;
        const f32x4 gg = *(const GAS f32x4*)(F.g_gla + e0);
        const v2u gw2 = *(const GAS v2u*)(PROJ + trow * NPROJ + C_GR + h * 128 + e0);
        float gr[4] = {bflo(gw2.x), bfhi(gw2.x), bflo(gw2.y), bfhi(gw2.y)}; float o[4];
#pragma unroll
        for (int r = 0; r < 4; ++r) o[r] = acc[mt][r] * rstd * gg[r] * (gr[r] / (1.f + __expf(-gr[r])));
        v2u w; w.x = pk2(o[0], o[1]); w.y = pk2(o[2], o[3]);
        *(GAS v2u*)(MIX + trow * DM + 512 + h * 128 + e0) = w; }
    __syncthreads();
}

constexpr int AT_BIAS = 0, AT_VST = 16384, BIAS_LD = 132;
template <int D>
__device__ __forceinline__ void attn_pattern(const bf16* Kb, const bf16* Vb, int tq0, const LAS float* bias, LAS unsigned char* vst,
                                             const bf16x8 (&qf)[2], float& Mrun, float& Lrun, f32x4 (&O)[4], int lane, int ns, int kofs) {
    constexpr int QS = 16 / D;
    const int i16 = lane & 15, g = lane >> 4;
    const int r = tq0 & (D - 1), lqb = tq0 / D, lq = lqb + QS * i16, lk0 = lqb + QS * 15 - kofs;
    bf16x8 kc[4], kn[4]; v4u vr[4], vn[4];
#define AT_KLOAD(dst, s_) do { const int ka_ = lk0 + 32 * (s_) + 8 * (i16 >> 2) + (i16 & 3), kb_ = ka_ + 4; \
        const int ta_ = (ka_ < 0 ? 0 : ka_) * D + r, tb_ = (kb_ < 0 ? 0 : kb_) * D + r; \
        const bf16* pa_ = Kb + (size_t)ta_ * NPROJ + 8 * g; const bf16* pb_ = Kb + (size_t)tb_ * NPROJ + 8 * g; \
        dst[0] = *(const GAS bf16x8*)pa_; dst[1] = *(const GAS bf16x8*)(pa_ + 32); dst[2] = *(const GAS bf16x8*)pb_; dst[3] = *(const GAS bf16x8*)(pb_ + 32); } while (0)
#define AT_VLOAD(dst, s_) do { _Pragma("unroll") for (int ii = 0; ii < 4; ++ii) { int lk_ = lk0 + 32 * (s_) + 8 * ii + (lane >> 3); lk_ = lk_ < 0 ? 0 : lk_; \
        dst[ii] = *(const GAS v4u*)(Vb + (size_t)(lk_ * D + r) * NPROJ + (lane & 7) * 8); } } while (0)
    AT_KLOAD(kc, 0); AT_VLOAD(vr, 0);
#pragma unroll 1
    for (int s = 0; s < ns; ++s) {
        const int sn = (s + 1 < ns) ? s + 1 : s;
        AT_KLOAD(kn, sn); AT_VLOAD(vn, sn);
        const f32x4 z = {0.f, 0.f, 0.f, 0.f};
        f32x4 sa = mfma16(kc[1], qf[1], mfma16(kc[0], qf[0], z));
        f32x4 sb = mfma16(kc[3], qf[1], mfma16(kc[2], qf[0], z));
        float mx = -1e30f;
#pragma unroll
        for (int e = 0; e < 4; ++e) {
            { const int lk = lk0 + 32 * s + 8 * g + e, rel = lq - lk; const bool ok = (rel >= 0) & (rel <= 128) & (lk >= 0);
              const float bv = bias[min(max(rel, 0), 128)]; const float v = (sa[e] + bv) + (ok ? 0.f : -1e30f); sa[e] = v; mx = fmaxf(mx, v); }
            { const int lk = lk0 + 32 * s + 8 * g + 4 + e, rel = lq - lk; const bool ok = (rel >= 0) & (rel <= 128) & (lk >= 0);
              const float bv = bias[min(max(rel, 0), 128)]; const float v = (sb[e] + bv) + (ok ? 0.f : -1e30f); sb[e] = v; mx = fmaxf(mx, v); }
        }
        mx = fmaxf(mx, __shfl_xor(mx, 16)); mx = fmaxf(mx, __shfl_xor(mx, 32));
        const float Mnew = fmaxf(Mrun, mx), alpha = __builtin_amdgcn_exp2f(Mrun - Mnew);
        Mrun = Mnew;
        float ls = 0.f;
#pragma unroll
        for (int e = 0; e < 4; ++e) { sa[e] = __builtin_amdgcn_exp2f(sa[e] - Mnew); sb[e] = __builtin_amdgcn_exp2f(sb[e] - Mnew); ls += sa[e] + sb[e]; }
        Lrun = Lrun * alpha + ls;
        const bf16x8 pf = pack8(sa, sb);
#pragma unroll
        for (int ii = 0; ii < 4; ++ii) *(LAS v4u*)(vst + (8 * ii + (lane >> 3)) * 128 + (lane & 7) * 16) = vr[ii];
#pragma unroll
        for (int mt = 0; mt < 4; ++mt) { const LAS unsigned char* p = vst + (8 * g + (i16 >> 2)) * 128 + (16 * mt + 4 * (i16 & 3)) * 2;
            O[mt] = mfma16(cat8(tr16(p), tr16(p + 512)), pf, O[mt] * alpha); }
#pragma unroll
        for (int q = 0; q < 4; ++q) { kc[q] = kn[q]; vr[q] = vn[q]; }
    }
#undef AT_KLOAD
#undef AT_VLOAD
}
__device__ __forceinline__ void attn_item(Frame& F, int it, LAS unsigned char* vst, const LAS float* biasT, int lane) {
    const int rho = it & 15, tile = (it >> 4) & 31, h = (it >> 9) & 7, b = it >> 12;
    const int tq0 = tile * 256 + rho, i16 = lane & 15, g = lane >> 4;
    const bf16* PROJ = WSP(bf16, WS_PROJ) + (size_t)b * SEQ * NPROJ;
    const bf16* qp = PROJ + (size_t)(tq0 + 16 * i16) * NPROJ + C_AQ + h * 64 + 8 * g;
    bf16x8 qf[2]; qf[0] = *(const GAS bf16x8*)qp; qf[1] = *(const GAS bf16x8*)(qp + 32);
    float Mrun = -1e30f, Lrun = 0.f; f32x4 O[4];
#pragma unroll
    for (int mt = 0; mt < 4; ++mt) O[mt] = (f32x4){0.f, 0.f, 0.f, 0.f};
    const bf16* Kb = PROJ + C_AK + h * 64; const bf16* Vb = PROJ + C_AV + h * 64;
    attn_pattern<1>(Kb, Vb, tq0, biasT + (0 * 8 + h) * BIAS_LD, vst, qf, Mrun, Lrun, O, lane, 12, 383);
    attn_pattern<4>(Kb, Vb, tq0, biasT + (1 * 8 + h) * BIAS_LD, vst, qf, Mrun, Lrun, O, lane, 6, 191);
    attn_pattern<16>(Kb, Vb, tq0, biasT + (2 * 8 + h) * BIAS_LD, vst, qf, Mrun, Lrun, O, lane, 5, 159);
    float L = Lrun; L += __shfl_xor(L, 16); L += __shfl_xor(L, 32);
    const float inv = 1.f / L;
    bf16* MIX = WSP(bf16, WS_XN) + ((size_t)b * SEQ + tq0 + 16 * i16) * DM + h * 64;
#pragma unroll
    for (int mt = 0; mt < 4; ++mt) { v2u w; w.x = pk2(O[mt][0] * inv, O[mt][1] * inv); w.y = pk2(O[mt][2] * inv, O[mt][3] * inv); *(GAS v2u*)(MIX + 16 * mt + 4 * g) = w; }
}
__device__ __forceinline__ int t5_bucket(int dist) {
    if (dist < 16) return dist;
    return 16 + (dist >= 22) + (dist >= 30) + (dist >= 40) + (dist >= 54) + (dist >= 73) + (dist >= 99) + (dist >= 134) + (dist >= 182) + (dist >= 246)
              + (dist >= 332) + (dist >= 450) + (dist >= 609) + (dist >= 825) + (dist >= 1117) + (dist >= 1513);
}
__device__ __forceinline__ void p3_attn_and_gla_prep(Frame& F) {
#ifndef NO_GLAPREP
    { const int half = F.wave >> 2, tl = F.tid & 255, wl = F.wave & 3; LAS unsigned char* L = F.lds + RING_OFF + half * GL_HALF;
      const int nh = F.G * 2;
      for (int base = 0; base < 1024; base += nh) { int item = base + F.vcu * 2 + half; item = item > 1023 ? 1023 : item; gla_prep_item(F, item, L, tl, wl, F.lane); }
    }
#endif
    __syncthreads();
    LAS float* biasT = (LAS float*)(F.lds + RING_OFF + AT_BIAS);
    for (int idx = F.tid; idx < 3 * 8 * 129; idx += NWAVES * 64) { const int p = idx / (8 * 129), rem = idx % (8 * 129), h = rem / 129, rel = rem % 129;
        const int dil = p == 0 ? 1 : (p == 1 ? 4 : 16);
        biasT[(p * 8 + h) * BIAS_LD + rel] = F.rel_bias[t5_bucket(rel * dil) * 8 + h] * LOG2E; }
    __syncthreads();
    LAS unsigned char* vst = F.lds + RING_OFF + AT_VST + F.wave * 4096;
    const int gw = F.vcu * NWAVES + F.wave, NGW = F.G * NWAVES;
#ifndef NO_ATTN
    for (int it = gw; it < 2 * 8 * 32 * 16; it += NGW) attn_item(F, it, vst, biasT, F.lane);
#endif
}
__device__ __forceinline__ void p5_gla_out(Frame& F) {
    const int half = F.wave >> 2, tl = F.tid & 255, wl = F.wave & 3; LAS unsigned char* L = F.lds + RING_OFF + half * GL_HALF5;
    const int nh = F.G * 2;
    for (int base = 0; base < 1024; base += nh) { int item = base + F.vcu * 2 + half; item = item > 1023 ? 1023 : item; gla_out_item(F, item, L, tl, wl, F.lane); }
}
__device__ __forceinline__ void p7_postmix(Frame& F) {
    const int gw = F.vcu * NWAVES + F.wave, NGW = F.G * NWAVES, lane = F.lane;
    const float* MOD = (const float*)(F.ctl + CW_MOD); const float* Y1 = WSP(float, WS_PROJ); bf16* XN = WSP(bf16, WS_XN);
    for (int m = gw; m < M; m += NGW) {
        const int b = m >> 13;
        const GAS f32x4* yr = (const GAS f32x4*)(Y1 + (size_t)m * DM) + lane; const GAS f32x4* xr = (const GAS f32x4*)(F.x + (size_t)m * DM) + lane;
        f32x4 y[4], xv[4]; float s = 0.f;
#pragma unroll
        for (int j = 0; j < 4; ++j) { y[j] = yr[64 * j]; xv[j] = xr[64 * j]; s += (y[j].x * y[j].x + y[j].y * y[j].y) + (y[j].z * y[j].z + y[j].w * y[j].w); }
        const float rstd = 1.f / sqrtf(wave_sum(s) * (1.f / DM) + EPS);
        float s1 = 0.f;
        GAS f32x4* orow = (GAS f32x4*)(F.out + (size_t)m * DM) + lane;
#pragma unroll
        for (int j = 0; j < 4; ++j) { const int col = 256 * j + 4 * lane;
            const f32x4 gp = *(const GAS f32x4*)(F.g_post_mix + col), ga = *(const GAS f32x4*)(MOD + b * MOD_LD + MOD_GA1 + col);
            xv[j] = xv[j] + ga * (y[j] * rstd * gp); orow[64 * j] = xv[j];
            s1 += (xv[j].x * xv[j].x + xv[j].y * xv[j].y) + (xv[j].z * xv[j].z + xv[j].w * xv[j].w); }
        const float rstd1 = 1.f / sqrtf(wave_sum(s1) * (1.f / DM) + EPS);
        GAS v2u* o8 = (GAS v2u*)(XN + (size_t)m * DM) + lane;
#pragma unroll
        for (int j = 0; j < 4; ++j) { const int col = 256 * j + 4 * lane;
            const f32x4 g = *(const GAS f32x4*)(F.g_pre_ffn + col), sc = *(const GAS f32x4*)(MOD + b * MOD_LD + MOD_SC2 + col), sh = *(const GAS f32x4*)(MOD + b * MOD_LD + MOD_SH2 + col);
            const f32x4 h = xv[j] * rstd1 * g * (sc + 1.f) + sh;
            v2u w; w.x = pk2(h.x, h.y); w.y = pk2(h.z, h.w); o8[64 * j] = w; }
    }
}

__device__ __forceinline__ unsigned umax_(unsigned a, unsigned b) { return a > b ? a : b; }
__device__ __forceinline__ unsigned umin_(unsigned a, unsigned b) { return a < b ? a : b; }
template <int N> __device__ __forceinline__ void bitonic_sort_desc(unsigned (&x)[N]) {
#pragma unroll
    for (int k = 2; k <= N; k <<= 1)
#pragma unroll
        for (int j = k >> 1; j > 0; j >>= 1)
#pragma unroll
            for (int i = 0; i < N; ++i) { const int l = i ^ j; if (l > i) { const unsigned a = x[i], b = x[l]; const bool desc = ((i & k) == 0);
                x[i] = desc ? umax_(a, b) : umin_(a, b); x[l] = desc ? umin_(a, b) : umax_(a, b); } }
}
__device__ __forceinline__ void merge16(unsigned (&a)[16], const unsigned (&b)[16]) {
#pragma unroll
    for (int i = 0; i < 16; ++i) a[i] = umax_(a[i], b[15 - i]);
#pragma unroll
    for (int j = 8; j > 0; j >>= 1)
#pragma unroll
        for (int i = 0; i < 16; ++i) { const int l = i ^ j; if (l > i) { const unsigned hi = umax_(a[i], a[l]), lo = umin_(a[i], a[l]); a[i] = hi; a[l] = lo; } }
}
__device__ __forceinline__ void p9_item(Frame& F, int it, int lane) {
    const int head = it & 7, tile = it >> 3, i16 = lane & 15, g = lane >> 4, tok = tile * 16 + i16;
    const bf16* Q = WSP(bf16, WS_PROJ) + (size_t)tok * PQD + head * 256;
    const bf16* SK = WSP(bf16, WS_SUBK) + (size_t)head * 2 * 128 * 128;
    unsigned top[2][16];
#pragma unroll
    for (int p = 0; p < 2; ++p) {
        bf16x8 Bq[4];
#pragma unroll
        for (int ks = 0; ks < 4; ++ks) Bq[ks] = *(const GAS bf16x8*)(Q + p * 128 + 32 * ks + 8 * g);
        unsigned lo[16], hi[16];
#pragma unroll
        for (int kt = 0; kt < 8; ++kt) {
            f32x4 acc = {0.f, 0.f, 0.f, 0.f};
            const bf16* ap = SK + (size_t)(p * 128 + 16 * kt + i16) * 128 + 8 * g;
#pragma unroll
            for (int ks = 0; ks < 4; ++ks) acc = mfma16(*(const GAS bf16x8*)(ap + 32 * ks), Bq[ks], acc);
#pragma unroll
            for (int r = 0; r < 4; ++r) { const int key = 16 * kt + 4 * g + r; float f = (acc[r] + 16.f) * 1048576.f; f = fminf(fmaxf(f, 0.f), 33554431.f);
                const unsigned pk = ((unsigned)f << 7) | (unsigned)(127 - key);
                if (kt < 4) lo[4 * kt + r] = pk; else hi[4 * (kt - 4) + r] = pk; }
        }
        bitonic_sort_desc<16>(lo); bitonic_sort_desc<16>(hi); merge16(lo, hi);
#pragma unroll
        for (int xr = 16; xr <= 32; xr <<= 1) {
#pragma unroll
            for (int i = 0; i < 16; ++i) hi[i] = (unsigned)__shfl_xor((int)lo[i], xr);
            merge16(lo, hi); }
#pragma unroll
        for (int i = 0; i < 16; ++i) top[p][i] = lo[i];
    }
    unsigned c[4][16];
#pragma unroll
    for (int q = 0; q < 4; ++q)
#pragma unroll
        for (int i = 0; i < 16; ++i) c[q][i] = 0u;
    {
        int n = 0;
#pragma unroll
        for (int i = 0; i < 16; ++i)
#pragma unroll
            for (int j = 0; j < 16; ++j) if ((i + 1) * (j + 1) <= 16) {
                const unsigned A = top[0][i], B = top[1][j];
                const unsigned ex = (127u - (A & 127u)) * 128u + (127u - (B & 127u));
                c[n >> 4][n & 15] = ((((A >> 7) + (B >> 7)) >> 8) << 14) | ex; ++n; }
    }
    bitonic_sort_desc<16>(c[0]); bitonic_sort_desc<16>(c[1]); bitonic_sort_desc<16>(c[2]); bitonic_sort_desc<16>(c[3]);
    merge16(c[0], c[1]); merge16(c[2], c[3]); merge16(c[0], c[2]);
    float ev[16]; float sum = 0.f;
    const float f0 = (float)(c[0][0] >> 14);
#pragma unroll
    for (int k = 0; k < 16; ++k) { ev[k] = __expf(((float)(c[0][k] >> 14) - f0) * (1.f / 4096.f)); sum += ev[k]; }
    const float inv = 1.f / sum;
    int* EIDX = WSP(int, WS_EIDX) + (size_t)tok * 128 + head * 16; float* GATE = WSP(float, WS_GATE) + (size_t)tok * 128 + head * 16;
#pragma unroll
    for (int k = 0; k < 16; ++k) if (g == (k >> 2)) { EIDX[k] = (int)(c[0][k] & 16383u); GATE[k] = ev[k] * inv; }
}
__device__ __forceinline__ void p9_topk(Frame& F) {
    const int gw = F.vcu * NWAVES + F.wave, NGW = F.G * NWAVES;
    for (int it = gw; it < (M / 16) * 8; it += NGW) p9_item(F, it, F.lane);
}

__device__ __forceinline__ void p10_peer(Frame& F) {
    const int gw = F.vcu * NWAVES + F.wave, NGW = F.G * NWAVES, lane = F.lane;
    const float* MOD = (const float*)(F.ctl + CW_MOD);
    const bf16* XN = WSP(bf16, WS_XN); const bf16* U16 = WSP(bf16, WS_U16); const bf16* V16 = WSP(bf16, WS_V16);
    const int* EIDX = WSP(int, WS_EIDX); const float* GATE = WSP(float, WS_GATE);
    for (int tok = gw; tok < M; tok += NGW) {
        const int b = tok >> 13;
        const v4u h0 = *(const GAS v4u*)(XN + (size_t)tok * DM + 8 * lane), h1 = *(const GAS v4u*)(XN + (size_t)tok * DM + 512 + 8 * lane);
        const int e0 = EIDX[(size_t)tok * 128 + lane], e1 = EIDX[(size_t)tok * 128 + 64 + lane];
        const float g0 = GATE[(size_t)tok * 128 + lane], g1 = GATE[(size_t)tok * 128 + 64 + lane];
        float w0 = 0.f, w1 = 0.f;
#pragma unroll 4
        for (int k = 0; k < 128; ++k) {
            const int e = __builtin_amdgcn_readlane(k < 64 ? e0 : e1, k & 63);
            const bf16* ur = U16 + (size_t)e * DM + 8 * lane;
            const v4u a = *(const GAS v4u*)ur, c = *(const GAS v4u*)(ur + 512);
            float s = 0.f, s2 = 0.f;
            s = dot2bf(a.x, h0.x, s); s2 = dot2bf(a.y, h0.y, s2); s = dot2bf(a.z, h0.z, s); s2 = dot2bf(a.w, h0.w, s2);
            s = dot2bf(c.x, h1.x, s); s2 = dot2bf(c.y, h1.y, s2); s = dot2bf(c.z, h1.z, s); s2 = dot2bf(c.w, h1.w, s2);
            s = wave_sum(s + s2);
            const float ge = 0.5f * s * (1.f + erff(s * 0.70710678118654752f));
            if (k < 64) { if (lane == k) w0 = ge; } else { if (lane == k - 64) w1 = ge; }
        }
        w0 *= g0; w1 *= g1;
        float acc[16];
#pragma unroll
        for (int i = 0; i < 16; ++i) acc[i] = 0.f;
#pragma unroll 4
        for (int k = 0; k < 128; ++k) {
            const int e = __builtin_amdgcn_readlane(k < 64 ? e0 : e1, k & 63);
            const float w = __builtin_bit_cast(float, __builtin_amdgcn_readlane(__builtin_bit_cast(int, k < 64 ? w0 : w1), k & 63));
            const bf16* vr = V16 + (size_t)e * DM + 8 * lane;
            const v4u a = *(const GAS v4u*)vr, c = *(const GAS v4u*)(vr + 512);
#pragma unroll
            for (int i = 0; i < 4; ++i) { acc[2 * i] += w * bflo(a[i]); acc[2 * i + 1] += w * bfhi(a[i]); acc[8 + 2 * i] += w * bflo(c[i]); acc[8 + 2 * i + 1] += w * bfhi(c[i]); }
        }
        float ss = 0.f;
#pragma unroll
        for (int i = 0; i < 16; ++i) ss += acc[i] * acc[i];
        const float rstd = 1.f / sqrtf(wave_sum(ss) * (1.f / DM) + EPS);
        float* orow = F.out + (size_t)tok * DM;
#pragma unroll
        for (int hlf = 0; hlf < 2; ++hlf)
#pragma unroll
            for (int q = 0; q < 2; ++q) { const int col = 512 * hlf + 8 * lane + 4 * q;
                const f32x4 x1 = *(const GAS f32x4*)(orow + col), gp = *(const GAS f32x4*)(F.g_post_ffn + col), ga = *(const GAS f32x4*)(MOD + b * MOD_LD + MOD_GA2 + col);
                f32x4 y; y.x = acc[8 * hlf + 4 * q]; y.y = acc[8 * hlf + 4 * q + 1]; y.z = acc[8 * hlf + 4 * q + 2]; y.w = acc[8 * hlf + 4 * q + 3];
                *(GAS f32x4*)(orow + col) = x1 + ga * (y * rstd * gp); }
    }
}

struct Args { const float* in[18]; float* out; unsigned char* ws; int ph_lo, ph_hi, li, pad; };
__global__ void __launch_bounds__(NWAVES * 64, 2) hyb_fwd(Args args) {
    extern __shared__ __attribute__((aligned(16))) unsigned char lds[];
    Frame F;
    F.lds = (LAS unsigned char*)lds;
    F.MISC = (volatile LAS unsigned*)(F.lds + MISC_OFF);
    F.tid = threadIdx.x; F.lane = F.tid & 63; F.wave = __builtin_amdgcn_readfirstlane(F.tid >> 6);
    F.G = gridDim.x; { const int bx = blockIdx.x; F.vcu = (F.G % 8 == 0) ? (bx % 8) * (F.G / 8) + bx / 8 : bx; }
    F.ws = args.ws; F.ctl = (gu32*)(args.ws + WS_CTL); F.out = args.out;
    F.x = args.in[0]; F.c = args.in[1]; F.w_ada = args.in[2]; F.b_ada = args.in[3]; F.g_pre_mix = args.in[4]; F.g_post_mix = args.in[5]; F.w_in = args.in[6];
    F.w_gate2 = args.in[7]; F.b_gate = args.in[8]; F.g_gla = args.in[9]; F.rel_bias = args.in[10]; F.w_out = args.in[11]; F.g_pre_ffn = args.in[12]; F.g_post_ffn = args.in[13];
    F.w_pq = args.in[14]; F.sub_keys = args.in[15]; F.peer_u = args.in[16]; F.peer_v = args.in[17];
    for (int u = F.tid; u < (LDS_BYTES - LDSCTL_OFF) / 4; u += NWAVES * 64) ((LAS unsigned*)(F.lds + LDSCTL_OFF))[u] = 0u;
    __syncthreads();
    const int lo = args.ph_lo, hi = args.ph_hi;
    const bool one = (hi - lo) > 1;
    XcdBarrier bar; bar.bar = (unsigned*)(F.ctl + CW_BAR); bar.x = 0; bar.st = nullptr;
    if (one) bar = xcd_barrier_post((unsigned*)(F.ctl + CW_BAR), F.MISC + 8);
#ifndef PH_MASK
#define PH_MASK 0x7ff
#endif
#define IN(k) (((PH_MASK >> (k)) & 1) && lo <= (k) && (k) < hi)
#define SEAM(k) do { if (IN(k) && IN((k) + 1)) xcd_barrier(bar); } while (0)
    if (IN(0)) { p0_prologue(F); SEAM(0); }
    if (IN(1)) { p1_modulate(F); SEAM(1); }
    if (IN(2)) {
        pg8::Gemm g{WSP(bf16, WS_XN), WSP(bf16, WS_WIN), M, NPROJ, DM}; pg8::StaticOrder S; S.init(M, NPROJ, F.G, (int)blockIdx.x);
        pg8::EpiProj E{WSP(bf16, WS_PROJ), NPROJ, 0, C2, 0.125f};
        pg8::gemm_phase<pg8::EpiProj, pg8::StaticOrder, PG8_ALIGN, PG8_SP2>(F.lds + RING_OFF, g, S, E);
        SEAM(2);
    }
    if (IN(3)) { p3_attn_and_gla_prep(F); SEAM(3); }
    if (IN(4)) { gla_scan(F); SEAM(4); }
    if (IN(5)) { p5_gla_out(F); SEAM(5); }
    if (IN(6)) {
        pg8::Gemm g{WSP(bf16, WS_XN), WSP(bf16, WS_WOUT), M, DM, DM}; pg8::StaticOrder S; S.init(M, DM, F.G, (int)blockIdx.x);
        pg8::EpiF32 E{WSP(float, WS_PROJ), DM};
        pg8::gemm_phase<pg8::EpiF32, pg8::StaticOrder, PG8_ALIGN, PG8_SP2>(F.lds + RING_OFF, g, S, E);
        SEAM(6);
    }
    if (IN(7)) { p7_postmix(F); SEAM(7); }
    if (IN(8)) {
        pg8::Gemm g{WSP(bf16, WS_XN), WSP(bf16, WS_WPQ), M, PQD, DM}; pg8::StaticOrder S; S.init(M, PQD, F.G, (int)blockIdx.x);
        pg8::EpiProj E{WSP(bf16, WS_PROJ), PQD, 1, 1.f, 1.f};
        pg8::gemm_phase<pg8::EpiProj, pg8::StaticOrder, PG8_ALIGN, PG8_SP2>(F.lds + RING_OFF, g, S, E);
        SEAM(8);
    }
    if (IN(9)) { p9_topk(F); SEAM(9); }
    if (IN(10)) { p10_peer(F); }
#undef IN
#undef SEAM
}

extern "C" void kernel_launch(void* const* d_in, const int* in_sizes, int n_in, void* d_out, int out_size, void* d_ws, size_t ws_size, hipStream_t stream) {
    static int grid = 0;
    if (grid == 0) {
        if (n_in != 18 || in_sizes[0] != M * DM || out_size != M * DM || ws_size < WS_END) { fprintf(stderr, "kernel_launch: unexpected shapes (n_in %d, in0 %d, out %d, ws %zu); nothing launched\n", n_in, n_in > 0 ? in_sizes[0] : -1, out_size, ws_size); grid = -1; return; }
        int dev = 0, cus = 0, per_cu = 0;
        if (hipGetDevice(&dev) != hipSuccess || hipDeviceGetAttribute(&cus, hipDeviceAttributeMultiprocessorCount, dev) != hipSuccess) { grid = -1; return; }
        if (hipFuncSetAttribute((const void*)hyb_fwd, hipFuncAttributeMaxDynamicSharedMemorySize, LDS_BYTES) != hipSuccess) { fprintf(stderr, "kernel_launch: hipFuncSetAttribute failed\n"); grid = -1; return; }
        if (hipOccupancyMaxActiveBlocksPerMultiprocessor(&per_cu, (const void*)hyb_fwd, NWAVES * 64, LDS_BYTES) != hipSuccess || per_cu < 1)
            fprintf(stderr, "kernel_launch: note: occupancy query reports %d workgroups per CU\n", per_cu);
        (void)hipGetLastError();
        grid = cus;
    }
    if (grid < 0) return;
    if (hipMemsetAsync((char*)d_ws + WS_CTL, 0, CTL_ZERO_BYTES, stream) != hipSuccess) { fprintf(stderr, "kernel_launch: hipMemsetAsync failed\n"); return; }
    Args a{};
    for (int i = 0; i < 18; ++i) a.in[i] = (const float*)d_in[i];
    a.out = (float*)d_out; a.ws = (unsigned char*)d_ws;
    const int nl = (MK_N_LAUNCHES == 1) ? 1 : NPHASES;
    for (int li = 0; li < nl; ++li) {
        a.ph_lo = (nl == 1) ? 0 : li; a.ph_hi = (nl == 1) ? NPHASES : li + 1; a.li = li;
        hipLaunchKernelGGL(hyb_fwd, dim3(grid), dim3(NWAVES * 64), LDS_BYTES, stream, a);
        const hipError_t le = hipPeekAtLastError();
        if (le != hipSuccess) { fprintf(stderr, "kernel_launch: launch %d failed: %s\n", li, hipGetErrorName(le)); break; }
    }
}
```

```cpp
#include <hip/hip_runtime.h>
#include <cstdio>
#include <cstdint>
namespace pg8 {
#define PG8_LAS __attribute__((address_space(3)))
typedef unsigned short bf16_t;
typedef short bf16x8 __attribute__((ext_vector_type(8)));
typedef float f32x4 __attribute__((ext_vector_type(4)));
typedef unsigned u32x4 __attribute__((ext_vector_type(4)));
constexpr int BM = 256, BK = 64, HALF = 128, HTB = HALF * BK * 2  , STAGE_BYTES = 8 * HTB, NXCD = 8, WGM = 8;

__host__ __device__ __forceinline__ int lds_byte(int r, int c) { const int st = (r >> 4) * 2 + (c >> 5), rr = r & 15, cc = c & 31, ob = rr * 64 + cc * 2; return st * 1024 + (ob ^ (((ob >> 9) & 1) << 5)); }
__host__ __device__ __forceinline__ void stage_rc(int b, int& R, int& C) { const int st = b / 1024, sb = b % 1024, swz = sb ^ (((sb >> 9) & 1) << 5); R = (st >> 1) * 16 + swz / 64; C = (st & 1) * 32 + (swz % 64) / 2; }
__host__ __device__ __forceinline__ int perm32(int rho) { const int n = rho >> 4, i = rho & 15; return 8 * (i >> 2) + 4 * n + (i & 3); }

struct Unit { int pm, pn; };
struct Gemm { const bf16_t* A; const bf16_t* Bt; int M, N, K; };

struct StaticOrder {
    int nM, nN, nwg, G, c;
    __host__ __device__ void init(int M, int N, int G_, int c_) { nM = M / BM; nN = N / BM; nwg = nM * nN; G = G_; c = c_; }
    __host__ __device__ bool next(int i, Unit& u) const {
        const long L = (long)i * G + c; if (L >= nwg) return false;
        int wgid = (int)L; { const int q = nwg / NXCD, r = nwg % NXCD, xcd = wgid % NXCD, off = wgid / NXCD; wgid = (xcd < r ? xcd * (q + 1) : r * (q + 1) + (xcd - r) * q) + off; }
        const int nig = WGM * nN, gid = wgid / nig, fm = gid * WGM, gsz = (nM - fm) < WGM ? (nM - fm) : WGM;
        u.pm = fm + ((wgid % nig) % gsz); u.pn = (wgid % nig) / gsz; return true;
    }
    __device__ __forceinline__ void a_ready(const Unit&) const {}
    __device__ __forceinline__ void done(const Unit&) const {}
};

__device__ __forceinline__ unsigned cvt_pk_bf16(float lo, float hi) { unsigned r; asm volatile("v_cvt_pk_bf16_f32 %0, %1, %2" : "=v"(r) : "v"(lo), "v"(hi)); return r; }
typedef float f32x2 __attribute__((ext_vector_type(2)));
__device__ __forceinline__ f32x2 gelu_pk(f32x2 v) {
    const f32x2 av = __builtin_elementwise_abs(v), d = av * 0.2316418882f + 1.0f;
    f32x2 t; t.x = __builtin_amdgcn_rcpf(d.x); t.y = __builtin_amdgcn_rcpf(d.y);
    f32x2 q = t * 0.5307027145f + (-0.7265760135f); q = q * t + 0.7107068705f; q = q * t + (-0.142248368f); q = q * t + 0.127414796f; q = q * t;
    const f32x2 s = (v * v) * (-0.72134752044f);
    f32x2 e; e.x = __builtin_amdgcn_exp2f(s.x); e.y = __builtin_amdgcn_exp2f(s.y);
    const f32x2 m = v * (q * e), r = v - m;
    f32x2 o; o.x = v.x < 0.f ? m.x : r.x; o.y = v.y < 0.f ? m.y : r.y; return o;
}

template <int ACT  > struct EpiBf16 {
    static constexpr bool PERM = true, AFTER_DRAIN = false; static_assert(ACT == 0 || ACT == 1, "EpiBf16: ACT is 0 (none) or 1 (gelu_pk)");
    bf16_t* O; int ldc; const float* bias; int split_cols; size_t split_stride; float scale0;
    __device__ __forceinline__ void operator()(const f32x4 (&acc)[2][2][4][2], const Unit& u, int wr, int wc, int fr, int fq) const {
        const int row0 = u.pm * BM + wr * 64 + fr; int colt = u.pn * BM; bf16_t* base = O;
        float sc = 1.f; if (split_cols) { const int t = colt / split_cols; base += (size_t)t * split_stride; colt -= t * split_cols; if (t == 0) sc = scale0; }
        const int col0 = colt + wc * 32 + 8 * fq, bcol0 = u.pn * BM + wc * 32 + 8 * fq;
        f32x4 bv[2][2];
#pragma unroll
        for (int bj = 0; bj < 2; ++bj)
#pragma unroll
            for (int n = 0; n < 2; ++n) bv[bj][n] = bias ? *(const f32x4*)(bias + bcol0 + bj * HALF + 4 * n) : (f32x4){0.f, 0.f, 0.f, 0.f};
#pragma unroll
        for (int ai = 0; ai < 2; ++ai)
#pragma unroll
            for (int m = 0; m < 4; ++m) { bf16_t* rowp = base + (size_t)(row0 + ai * HALF + m * 16) * ldc + col0;
#pragma unroll
                for (int bj = 0; bj < 2; ++bj) { f32x4 v0 = acc[ai][bj][m][0] + bv[bj][0], v1 = acc[ai][bj][m][1] + bv[bj][1];
                    if (ACT == 1) { f32x2 a = gelu_pk((f32x2){v0[0], v0[1]}), b = gelu_pk((f32x2){v0[2], v0[3]}), c = gelu_pk((f32x2){v1[0], v1[1]}), d = gelu_pk((f32x2){v1[2], v1[3]});
                        v0 = (f32x4){a.x, a.y, b.x, b.y}; v1 = (f32x4){c.x, c.y, d.x, d.y}; }
                    v0 = v0 * sc; v1 = v1 * sc; u32x4 w; w.x = cvt_pk_bf16(v0[0], v0[1]); w.y = cvt_pk_bf16(v0[2], v0[3]); w.z = cvt_pk_bf16(v1[0], v1[1]); w.w = cvt_pk_bf16(v1[2], v1[3]);
                    *(u32x4*)(rowp + bj * HALF) = w; } }
    }
};
struct EpiProj {
    static constexpr bool PERM = true, AFTER_DRAIN = false;
    bf16_t* O; int ldc; int mode; float s_aq, s_gq;
    __device__ __forceinline__ void operator()(const f32x4 (&acc)[2][2][4][2], const Unit& u, int wr, int wc, int fr, int fq) const {
        const int row0 = u.pm * BM + wr * 64 + fr; const int col0 = u.pn * BM + wc * 32 + 8 * fq;
        float sc = 1.f; if (mode == 0) sc = (u.pn < 2) ? s_aq : (u.pn == 6 ? s_gq : 1.f);
#pragma unroll
        for (int ai = 0; ai < 2; ++ai)
#pragma unroll
            for (int m = 0; m < 4; ++m) { bf16_t* rowp = O + (size_t)(row0 + ai * HALF + m * 16) * ldc + col0;
#pragma unroll
                for (int bj = 0; bj < 2; ++bj) { f32x4 v0 = acc[ai][bj][m][0] * sc, v1 = acc[ai][bj][m][1] * sc;
                    u32x4 w; w.x = cvt_pk_bf16(v0[0], v0[1]); w.y = cvt_pk_bf16(v0[2], v0[3]); w.z = cvt_pk_bf16(v1[0], v1[1]); w.w = cvt_pk_bf16(v1[2], v1[3]);
                    *(u32x4*)(rowp + bj * HALF) = w; } }
    }
};
struct EpiF32 {
    static constexpr bool PERM = false, AFTER_DRAIN = false;
    float* O; int ldc;
    __device__ __forceinline__ void operator()(const f32x4 (&acc)[2][2][4][2], const Unit& u, int wr, int wc, int fr, int fq) const {
        const int col0 = u.pn * BM + wc * 32 + 4 * fq;
#pragma unroll
        for (int ai = 0; ai < 2; ++ai)
#pragma unroll
            for (int m = 0; m < 4; ++m) { const size_t off = (size_t)(u.pm * BM + ai * HALF + wr * 64 + m * 16 + fr) * ldc + col0;
#pragma unroll
                for (int bj = 0; bj < 2; ++bj)
#pragma unroll
                    for (int n = 0; n < 2; ++n) *(f32x4*)(O + off + bj * HALF + n * 16) = acc[ai][bj][m][n]; }
    }
};
template <class Epi, class Sched, bool ALIGN_EPI = false, bool SP2 = false>
__device__ __forceinline__ void gemm_phase(PG8_LAS unsigned char* lds, const Gemm g, const Sched& S, const Epi& E) {
    const int tid = threadIdx.x, wid = __builtin_amdgcn_readfirstlane(tid >> 6), lane = tid & 63, wr = wid >> 2, wc = wid & 3, fr = lane & 15, fq = lane >> 4;
    const int K = g.K, nt = K / BK;
    unsigned voffA[2], voffB[2];
#pragma unroll
    for (int i = 0; i < 2; ++i) { int R, C; stage_rc(tid * 16 + i * 8192, R, C); const int Rb = Epi::PERM ? ((R & ~31) + perm32(R & 31)) : R;
        voffA[i] = (unsigned)(R * K + C) * 2u; voffB[i] = (unsigned)(Rb * K + C) * 2u; }
    const size_t kstep = (size_t)(BK * 2);
    const size_t hstep = (size_t)HALF * K * 2;
    const size_t tstep = 2 * hstep;
    const unsigned ldsw = (unsigned)wid * 1024u;
    const int aoff = lds_byte(wr * 64 + fr, fq * 8), boff = lds_byte(wc * 32 + fr, fq * 8);
#define PG8_SA(b, h) (((b) * 2 + (h)) * HTB)
#define PG8_SB(b, h) ((4 + (b) * 2 + (h)) * HTB)
#define PG8_STAGE(bufoff, gbase, voff) do { _Pragma("unroll") for (int _i = 0; _i < 2; ++_i) \
        __builtin_amdgcn_global_load_lds((const unsigned*)((const char*)(gbase) + (voff)[_i]), (PG8_LAS unsigned*)(lds + (bufoff) + ldsw + _i * 8192), 16, 0, 0); } while (0)
#define PG8_LDA(dst, b, h) do { _Pragma("unroll") for (int m = 0; m < 4; ++m) _Pragma("unroll") for (int k = 0; k < 2; ++k) dst[m][k] = *(const PG8_LAS bf16x8*)(lds + PG8_SA(b, h) + aoff + m * 2048 + k * 1024); } while (0)
#define PG8_LDB(dst, b, h) do { _Pragma("unroll") for (int n = 0; n < 2; ++n) _Pragma("unroll") for (int k = 0; k < 2; ++k) dst[n][k] = *(const PG8_LAS bf16x8*)(lds + PG8_SB(b, h) + boff + n * 2048 + k * 1024); } while (0)
#define PG8_MMA(ai, bj, At, Bt) do { __builtin_amdgcn_s_setprio(1); _Pragma("unroll") for (int m = 0; m < 4; ++m) _Pragma("unroll") for (int n = 0; n < 2; ++n) _Pragma("unroll") for (int k = 0; k < 2; ++k) \
        acc[ai][bj][m][n] = __builtin_amdgcn_mfma_f32_16x16x32_bf16(Bt[n][k], At[m][k], acc[ai][bj][m][n], 0, 0, 0); __builtin_amdgcn_s_setprio(0); } while (0)
#define PG8_WAIT_V(n) asm volatile("s_waitcnt vmcnt(" #n ")" ::: "memory")
#define PG8_WAIT_L(n) asm volatile("s_waitcnt lgkmcnt(" #n ")" ::: "memory")
#define PG8_BAR __builtin_amdgcn_s_barrier()
#define PG8_SCHED __builtin_amdgcn_sched_barrier(0)
    Unit cur, nxt; int ui = 0;
    if (!S.next(0, cur)) return;
    f32x4 acc[2][2][4][2];
#pragma unroll
    for (int a = 0; a < 2; ++a)
#pragma unroll
        for (int b = 0; b < 2; ++b)
#pragma unroll
            for (int m = 0; m < 4; ++m)
#pragma unroll
                for (int n = 0; n < 2; ++n) acc[a][b][m][n] = (f32x4){0.f, 0.f, 0.f, 0.f};
    bf16x8 At[4][2], B0[2][2], B1[2][2];
    const char* cA = (const char*)g.A + (size_t)cur.pm * tstep; const char* cB = (const char*)g.Bt + (size_t)cur.pn * tstep;
    S.a_ready(cur);
    if constexpr (SP2) {
        PG8_STAGE(PG8_SB(0, 0), cB, voffB); PG8_STAGE(PG8_SB(0, 1), cB + hstep, voffB); PG8_STAGE(PG8_SA(0, 0), cA, voffA); PG8_STAGE(PG8_SA(0, 1), cA + hstep, voffA);
        if (wr == 1) PG8_BAR;
        PG8_WAIT_V(2); PG8_BAR;
        PG8_STAGE(PG8_SB(1, 0), cB + kstep, voffB); PG8_STAGE(PG8_SA(1, 0), cA + kstep, voffA); PG8_STAGE(PG8_SB(1, 1), cB + hstep + kstep, voffB);
        PG8_WAIT_V(6); PG8_BAR;
    } else {
        PG8_STAGE(PG8_SB(0, 0), cB, voffB); PG8_STAGE(PG8_SA(0, 0), cA, voffA); PG8_STAGE(PG8_SB(0, 1), cB + hstep, voffB); PG8_STAGE(PG8_SA(0, 1), cA + hstep, voffA);
        if (wr == 1) PG8_BAR;
        PG8_WAIT_V(4); PG8_BAR;
        PG8_STAGE(PG8_SB(1, 0), cB + kstep, voffB); PG8_STAGE(PG8_SA(1, 0), cA + kstep, voffA); PG8_STAGE(PG8_SB(1, 1), cB + hstep + kstep, voffB);
        PG8_WAIT_V(6); PG8_BAR;
    }
    for (;;) {
        const bool has_next = S.next(ui + 1, nxt);
        const char* nA = has_next ? (const char*)g.A + (size_t)nxt.pm * tstep : cA; const char* nB = has_next ? (const char*)g.Bt + (size_t)nxt.pn * tstep : cB;
        for (int t = 0; t < nt; t += 2) {
            const bool last = (t == nt - 2);
            const char* a1 = cA + (size_t)(t + 1) * kstep;
            const char* a2 = last ? nA : cA + (size_t)(t + 2) * kstep; const char* b2 = last ? nB : cB + (size_t)(t + 2) * kstep;
            const char* a3 = a2 + kstep; const char* b3 = b2 + kstep;
            if (last && has_next) S.a_ready(nxt);
            if constexpr (SP2) {
            PG8_LDB(B0, 0, 0); PG8_LDB(B1, 0, 1); PG8_SCHED; PG8_LDA(At, 0, 0); PG8_STAGE(PG8_SA(1, 1), a1 + hstep, voffA);
            PG8_WAIT_V(8); PG8_WAIT_L(0); PG8_BAR; PG8_MMA(0, 0, At, B0); PG8_MMA(0, 1, At, B1); PG8_BAR; PG8_SCHED;
            PG8_LDA(At, 0, 1); PG8_STAGE(PG8_SB(0, 0), b2, voffB); PG8_STAGE(PG8_SB(0, 1), b2 + hstep, voffB); PG8_STAGE(PG8_SA(0, 0), a2, voffA);
            PG8_WAIT_V(8); PG8_WAIT_L(0); PG8_BAR; PG8_MMA(1, 0, At, B0); PG8_MMA(1, 1, At, B1); PG8_BAR; PG8_SCHED;
            PG8_LDB(B0, 1, 0); PG8_LDB(B1, 1, 1); PG8_SCHED; PG8_LDA(At, 1, 0); PG8_STAGE(PG8_SA(0, 1), a2 + hstep, voffA);
            PG8_WAIT_V(8); PG8_WAIT_L(0); PG8_BAR; PG8_MMA(0, 0, At, B0); PG8_MMA(0, 1, At, B1); PG8_BAR; PG8_SCHED;
            PG8_LDA(At, 1, 1); PG8_STAGE(PG8_SB(1, 0), b3, voffB); PG8_STAGE(PG8_SB(1, 1), b3 + hstep, voffB); PG8_STAGE(PG8_SA(1, 0), a3, voffA);
            PG8_WAIT_V(8); PG8_WAIT_L(0); PG8_BAR; PG8_MMA(1, 0, At, B0); PG8_MMA(1, 1, At, B1); PG8_BAR; PG8_SCHED;
            } else {
            PG8_LDB(B0, 0, 0); PG8_SCHED; PG8_LDA(At, 0, 0); PG8_STAGE(PG8_SA(1, 1), a1 + hstep, voffA);
            PG8_WAIT_L(8); PG8_BAR; PG8_WAIT_L(0); PG8_MMA(0, 0, At, B0); PG8_BAR; PG8_SCHED;
            PG8_LDB(B1, 0, 1); PG8_STAGE(PG8_SB(0, 0), b2, voffB);
            PG8_BAR; PG8_WAIT_L(0); PG8_MMA(0, 1, At, B1); PG8_BAR;
            PG8_LDA(At, 0, 1); PG8_STAGE(PG8_SA(0, 0), a2, voffA);
            PG8_BAR; PG8_WAIT_L(0); PG8_MMA(1, 0, At, B0); PG8_BAR; PG8_SCHED;
            PG8_STAGE(PG8_SB(0, 1), b2 + hstep, voffB);
            PG8_WAIT_V(6); PG8_BAR; PG8_MMA(1, 1, At, B1); PG8_BAR;
            PG8_LDB(B0, 1, 0); PG8_SCHED; PG8_LDA(At, 1, 0); PG8_STAGE(PG8_SA(0, 1), a2 + hstep, voffA);
            PG8_WAIT_L(8); PG8_BAR; PG8_WAIT_L(0); PG8_MMA(0, 0, At, B0); PG8_BAR; PG8_SCHED;
            PG8_LDB(B1, 1, 1); PG8_STAGE(PG8_SB(1, 0), b3, voffB);
            PG8_BAR; PG8_WAIT_L(0); PG8_MMA(0, 1, At, B1); PG8_BAR;
            PG8_LDA(At, 1, 1); PG8_STAGE(PG8_SA(1, 0), a3, voffA);
            PG8_BAR; PG8_WAIT_L(0); PG8_MMA(1, 0, At, B0); PG8_BAR; PG8_SCHED;
            PG8_STAGE(PG8_SB(1, 1), b3 + hstep, voffB);
            PG8_WAIT_V(6); PG8_BAR; PG8_MMA(1, 1, At, B1); PG8_BAR;
            }
        }
        if constexpr (ALIGN_EPI) { if (wr == 0) PG8_BAR; }
        if constexpr (!Epi::AFTER_DRAIN) { E(acc, cur, wr, wc, fr, fq); S.done(cur); }
        if (!has_next) break;
#pragma unroll
        for (int a = 0; a < 2; ++a)
#pragma unroll
            for (int b = 0; b < 2; ++b)
#pragma unroll
                for (int m = 0; m < 4; ++m)
#pragma unroll
                    for (int n = 0; n < 2; ++n) acc[a][b][m][n] = (f32x4){0.f, 0.f, 0.f, 0.f};
        cur = nxt; cA = nA; cB = nB; ++ui;
        if constexpr (ALIGN_EPI) { if (wr == 1) PG8_BAR; }
    }
    PG8_WAIT_V(0);
    if constexpr (!ALIGN_EPI) { if (wr == 0) PG8_BAR; }
    PG8_BAR;
    if constexpr (Epi::AFTER_DRAIN) { E.fused(acc, cur, wr, wc, fr, fq, lds, wid, lane); S.done(cur); }
#undef PG8_SA
#undef PG8_SB
#undef PG8_STAGE
#undef PG8_LDA
#undef PG8_LDB
#undef PG8_MMA
#undef PG8_WAIT_V
#undef PG8_WAIT_L
#undef PG8_BAR
#undef PG8_SCHED
}
}
#ifndef PG8_SP2
#define PG8_SP2 true
#endif
#ifndef PG8_ALIGN
#define PG8_ALIGN true
#endif

constexpr int NWAVES = 8;
#ifndef MK_N_LAUNCHES
#define MK_N_LAUNCHES 1
#endif
constexpr int NPHASES = 13;

constexpr int BATCH = 2, SEQ = 8192, DM = 1024, M = BATCH * SEQ;
constexpr int DIN = 3088, NPROJ = 3072;
constexpr int C_AQ = 0, C_AK = 512, C_AV = 1024, C_GQ = 1536, C_GK = 1792, C_GV = 2048, C_GR = 2560, C_GLR = 3072;
constexpr int NH = 8;
constexpr int GH = 4, GDK = 64, GDV = 128, NCHUNK = SEQ / 64;
constexpr int PQD = 2048, NEXP = 16384;
constexpr float EPS = 1e-6f;
constexpr float LOG2E = 1.4426950408889634f;
constexpr float C2 = 0.125f * LOG2E;

constexpr size_t MiB = 1u << 20;
constexpr size_t WS_CTL = 0, CTL_ZERO_BYTES = 1 * MiB;
constexpr size_t WS_WIN = 2 * MiB, WS_WOUT = 8 * MiB, WS_WPQ = 10 * MiB, WS_SUBK = 14 * MiB, WS_DEC = 15 * MiB;
constexpr size_t WS_U16 = 16 * MiB, WS_V16 = 48 * MiB;
constexpr size_t WS_XN = 80 * MiB;
constexpr size_t WS_PROJ = 112 * MiB;
constexpr size_t WS_EIDX = 176 * MiB, WS_GATE = 184 * MiB;
constexpr size_t WS_PART = 192 * MiB;
constexpr size_t WS_Y2 = 112 * MiB;
constexpr size_t WS_LOGA = 208 * MiB;
constexpr size_t WS_UT = 224 * MiB, WS_END = 256 * MiB;
constexpr int CW_TMO = 0, CW_BAR = 4096, CW_MOD = 65536;
constexpr int MOD_SH1 = 0, MOD_SC1 = 1024, MOD_GA1 = 2048, MOD_SH2 = 3072, MOD_SC2 = 4096, MOD_GA2 = 5120, MOD_LD = 6144;

constexpr int RING_OFF = 0, RING_BYTES = 131072;
constexpr int LDSCTL_OFF = RING_BYTES, MISC_OFF = LDSCTL_OFF + 320;
constexpr int LDS_BYTES = 147456;

#define GAS __attribute__((address_space(1)))
#define LAS __attribute__((address_space(3)))
typedef unsigned short bf16;
typedef unsigned v4u __attribute__((ext_vector_type(4)));
typedef unsigned v2u __attribute__((ext_vector_type(2)));
typedef float f32x4 __attribute__((ext_vector_type(4)));
typedef float f32x2 __attribute__((ext_vector_type(2)));
typedef short bf16x8 __attribute__((ext_vector_type(8)));
typedef short s16x4 __attribute__((ext_vector_type(4)));
typedef __bf16 bf16x2_t __attribute__((ext_vector_type(2)));
typedef GAS unsigned gu32;
#define RLX_AGENT __ATOMIC_RELAXED, __HIP_MEMORY_SCOPE_AGENT
#define LDS_WAIT() asm volatile("s_waitcnt lgkmcnt(0)" ::: "memory")
#define VM_WAIT() asm volatile("s_waitcnt vmcnt(0)" ::: "memory")
__device__ __forceinline__ unsigned f2bf(float f) { unsigned u = __builtin_bit_cast(unsigned, f); return (u + 0x7fffu + ((u >> 16) & 1u)) >> 16; }
__device__ __forceinline__ unsigned pk2(float lo, float hi) { f32x2 v = {lo, hi}; bf16x2_t b = __builtin_convertvector(v, bf16x2_t); return __builtin_bit_cast(unsigned, b); }
__device__ __forceinline__ float bflo(unsigned w) { return __builtin_bit_cast(float, w << 16); }
__device__ __forceinline__ float bfhi(unsigned w) { return __builtin_bit_cast(float, w & 0xffff0000u); }
__device__ __forceinline__ float dot2bf(unsigned a, unsigned b, float acc) { return __builtin_amdgcn_fdot2_f32_bf16(__builtin_bit_cast(bf16x2_t, a), __builtin_bit_cast(bf16x2_t, b), acc, false); }
__device__ __forceinline__ f32x4 mfma16(bf16x8 a, bf16x8 b, f32x4 c) { return __builtin_amdgcn_mfma_f32_16x16x32_bf16(a, b, c, 0, 0, 0); }
typedef short v4i16_t __attribute__((ext_vector_type(4)));
__device__ __forceinline__ s16x4 tr16(const LAS unsigned char* p) { return __builtin_bit_cast(s16x4, __builtin_amdgcn_ds_read_tr16_b64_v4i16((LAS v4i16_t*)p)); }
__device__ __forceinline__ bf16x8 cat8(s16x4 lo, s16x4 hi) { return (bf16x8){lo[0], lo[1], lo[2], lo[3], hi[0], hi[1], hi[2], hi[3]}; }
__device__ __forceinline__ bf16x8 pack8(f32x4 a, f32x4 b) { v4u w; w.x = pk2(a[0], a[1]); w.y = pk2(a[2], a[3]); w.z = pk2(b[0], b[1]); w.w = pk2(b[2], b[3]); return __builtin_bit_cast(bf16x8, w); }
__device__ __forceinline__ float wave_sum(float v) {
#pragma unroll
    for (int o = 1; o < 64; o <<= 1) v += __shfl_xor(v, o);
    return v;
}

#define XB_TMO      128
#define XB_XCNT(j)  (256  + 64 * (j))
#define XB_XSUB(j)  (1280 + 64 * (j))
#define XB_XGEN(j)  (2304 + 64 * (j))
#define XB_TOP      3328
#define XB_TOPGEN   3392
#define XCD_BAR_WORDS 3456
#define XB_SPIN_CAP (1u << 18)
__device__ __forceinline__ unsigned xb_ld(unsigned* p)              { return __hip_atomic_load(p, __ATOMIC_RELAXED, __HIP_MEMORY_SCOPE_AGENT); }
__device__ __forceinline__ unsigned xb_add(unsigned* p, unsigned v) { return __hip_atomic_fetch_add(p, v, __ATOMIC_RELAXED, __HIP_MEMORY_SCOPE_AGENT); }
__device__ __forceinline__ unsigned xb_xcc_id() { return (unsigned)__builtin_amdgcn_s_getreg((3 << 11) | 20) & 0xFu; }
#define XB_SPIN(cond, bar) do { unsigned _sp = 0; while (cond) { __builtin_amdgcn_s_sleep(1); \
    if ((++_sp & 255u) == 0u) { if (xb_ld(&(bar)[XB_TMO])) break; if (_sp > XB_SPIN_CAP) { atomicAdd(&(bar)[XB_TMO], 1u); break; } } } } while (0)
struct XcdBarrier { unsigned* bar; unsigned x; volatile LAS unsigned* st; };
__device__ __forceinline__ XcdBarrier xcd_barrier_post(unsigned* bar, volatile LAS unsigned* st) {
    XcdBarrier b; b.bar = bar; b.x = xb_xcc_id(); b.st = st;
    if (threadIdx.x == 0) (void)xb_add(&bar[XB_XCNT(b.x)], 1u);
    return b;
}
__device__ __forceinline__ void xcd_barrier_complete(unsigned* bar, unsigned x, unsigned& nloc, unsigned& nx) {
    const unsigned G = gridDim.x * gridDim.y * gridDim.z;
    unsigned sum, cnt, mine, sp = 0u;
    for (;;) {
        sum = 0u; cnt = 0u; mine = 0u;
#pragma unroll
        for (unsigned j = 0; j < 16; ++j) { const unsigned c = xb_ld(&bar[XB_XCNT(j)]); sum += c; cnt += (c > 0u) ? 1u : 0u; mine = (j == x) ? c : mine; }
        if (sum == G) break;
        __builtin_amdgcn_s_sleep(1);
        if ((++sp & 255u) == 0u) { if (xb_ld(&bar[XB_TMO])) break; if (sp > XB_SPIN_CAP) { atomicAdd(&bar[XB_TMO], 1u); break; } }
    }
    nloc = mine > 0u ? mine : 1u; nx = cnt > 0u ? cnt : 1u;
}
__device__ __forceinline__ void xcd_barrier(const XcdBarrier& b) {
    asm volatile("s_waitcnt vmcnt(0)" ::: "memory");
    __syncthreads();
    if (threadIdx.x == 0) {
        unsigned* bar = b.bar;
        __builtin_amdgcn_s_waitcnt(0);
        unsigned nloc = b.st[0], nx = b.st[1];
        if (nloc == 0u) { xcd_barrier_complete(bar, b.x, nloc, nx); b.st[0] = nloc; b.st[1] = nx; }
        const unsigned old = xb_add(&bar[XB_XSUB(b.x)], 1u);
        const unsigned gen = old / nloc;
        if (old + 1u == (gen + 1u) * nloc) {
            __builtin_amdgcn_fence(__ATOMIC_RELEASE, "agent");
            asm volatile("s_waitcnt vmcnt(0)" ::: "memory");
            const unsigned og = xb_add(&bar[XB_TOP], 1u);
            const unsigned tg = og / nx;
            if (og + 1u == (tg + 1u) * nx) xb_add(&bar[XB_TOPGEN], 1u);
            else XB_SPIN(xb_ld(&bar[XB_TOPGEN]) == tg, bar);
            __builtin_amdgcn_fence(__ATOMIC_ACQUIRE, "agent");
            xb_add(&bar[XB_XGEN(b.x)], 1u);
            asm volatile("s_waitcnt vmcnt(0)" ::: "memory");
        } else {
            XB_SPIN(xb_ld(&bar[XB_XGEN(b.x)]) == gen, bar);
            __builtin_amdgcn_fence(__ATOMIC_ACQUIRE, "agent");
            asm volatile("s_waitcnt vmcnt(0)" ::: "memory");
        }
    }
    __syncthreads();
}

struct Frame {
    LAS unsigned char* lds;
    volatile LAS unsigned* MISC;
    gu32* ctl;
    int tid, lane, wave;
    int vcu, G;
    const float *x, *c, *w_ada, *b_ada, *g_pre_mix, *g_post_mix, *w_in, *w_gate2, *b_gate, *g_gla, *rel_bias, *w_out, *g_pre_ffn, *g_post_ffn, *w_pq, *sub_keys, *peer_u, *peer_v;
    float* out;
    unsigned char* ws;
};
#define WSP(T, off) ((T*)(F.ws + (off)))

__device__ __forceinline__ void p0_transpose_item(const float* W, int ldw, int K, int nblk, bf16* WT, LAS float* scr, int item, int lane) {
    const int kb = item / nblk, nb = item % nblk, k0 = 64 * kb, n0 = 32 * nb;
#pragma unroll 8
    for (int i = 0; i < 32; ++i) { const int kk = 2 * i + (lane >> 5); scr[kk * 33 + (lane & 31)] = W[(size_t)(k0 + kk) * ldw + n0 + (lane & 31)]; }
    LDS_WAIT(); asm volatile("" ::: "memory");
    const int c = lane & 7;
#pragma unroll
    for (int j = 0; j < 4; ++j) { const int n = (lane >> 3) + 8 * j; const LAS float* s = scr + (8 * c) * 33 + n;
        v4u o; o.x = pk2(s[0 * 33], s[1 * 33]); o.y = pk2(s[2 * 33], s[3 * 33]); o.z = pk2(s[4 * 33], s[5 * 33]); o.w = pk2(s[6 * 33], s[7 * 33]);
        *(GAS v4u*)(WT + (size_t)(n0 + n) * K + k0 + 8 * c) = o; }
    LDS_WAIT(); asm volatile("" ::: "memory");
}
__device__ __forceinline__ void cvt_stream(const float* src, bf16* dst, size_t nvec8, int gw, int NGW, int lane) {
    for (size_t i = (size_t)gw * 64 + lane; i < nvec8; i += (size_t)NGW * 64) {
        const f32x4 a = *(const GAS f32x4*)(src + i * 8), b = *(const GAS f32x4*)(src + i * 8 + 4);
        v4u o; o.x = pk2(a[0], a[1]); o.y = pk2(a[2], a[3]); o.z = pk2(b[0], b[1]); o.w = pk2(b[2], b[3]);
        *(GAS v4u*)(dst + i * 8) = o; }
}
__device__ __forceinline__ void cvt_sliced(const float* src, bf16* dst, int gw, int NGW, int lane) {
    const size_t nvec8 = (size_t)NEXP * DM / 8;
    for (size_t i = (size_t)gw * 64 + lane; i < nvec8; i += (size_t)NGW * 64) {
        const f32x4 a = *(const GAS f32x4*)(src + i * 8), b = *(const GAS f32x4*)(src + i * 8 + 4);
        v4u o; o.x = pk2(a[0], a[1]); o.y = pk2(a[2], a[3]); o.z = pk2(b[0], b[1]); o.w = pk2(b[2], b[3]);
        const size_t e = i >> 7; const int cv = (int)(i & 127), sl = cv >> 4, wi = (cv & 15) * 8;
        *(GAS v4u*)(dst + ((size_t)sl * NEXP + e) * 128 + wi) = o; }
}
__device__ __forceinline__ void p0_prologue(Frame& F) {
    LAS float* scr = (LAS float*)(F.lds + RING_OFF + F.wave * 16384);
    const int gw = F.vcu * NWAVES + F.wave, NGW = F.G * NWAVES, lane = F.lane;
    float* MOD = (float*)(F.ctl + CW_MOD);
    for (int nb = F.vcu; nb < 96; nb += F.G) {
        const int n = nb * 64 + lane;
        float a0 = 0.f, a1 = 0.f;
#pragma unroll 8
        for (int kk = 0; kk < 128; ++kk) { const int k = F.wave * 128 + kk; const float w = F.w_ada[(size_t)k * 6144 + n];
            const float c0 = F.c[k], c1 = F.c[1024 + k];
            a0 += (c0 / (1.f + __expf(-c0))) * w; a1 += (c1 / (1.f + __expf(-c1))) * w; }
        LAS float* red = (LAS float*)(F.lds + RING_OFF + F.wave * 16384 + 12288);
        red[lane] = a0; red[64 + lane] = a1;
        __syncthreads();
        if (F.wave == 0) {
            float s0 = F.b_ada[n], s1 = s0;
#pragma unroll
            for (int w = 0; w < 8; ++w) { const LAS float* rw = (const LAS float*)(F.lds + RING_OFF + w * 16384 + 12288); s0 += rw[lane]; s1 += rw[64 + lane]; }
            MOD[n] = s0; MOD[MOD_LD + n] = s1;
        }
        __syncthreads();
    }
    constexpr int I_IN = 16 * 96, I_OUT = 16 * 32, I_PQ = 16 * 64;
    for (int it = gw; it < I_IN + I_OUT + I_PQ; it += NGW) {
        int r = it;
        if (r < I_IN) { p0_transpose_item(F.w_in, DIN, DM, 96, WSP(bf16, WS_WIN), scr, r, lane); continue; } r -= I_IN;
        if (r < I_OUT) { p0_transpose_item(F.w_out, DM, DM, 32, WSP(bf16, WS_WOUT), scr, r, lane); continue; } r -= I_OUT;
        p0_transpose_item(F.w_pq, PQD, DM, 64, WSP(bf16, WS_WPQ), scr, r, lane);
    }
    cvt_stream(F.sub_keys, WSP(bf16, WS_SUBK), (size_t)8 * 2 * 128 * 128 / 8, gw, NGW, lane);
    cvt_sliced(F.peer_u, WSP(bf16, WS_U16), gw, NGW, lane);
    cvt_sliced(F.peer_v, WSP(bf16, WS_V16), gw, NGW, lane);
}

constexpr int P1_WGL = 0, P1_WG2 = 81920, P1_BG = 98304;
__device__ __forceinline__ float log_sigmoid(float z) { return fminf(z, 0.f) - log1pf(__expf(-fabsf(z))); }
__device__ __forceinline__ void p1_modulate(Frame& F) {
    LAS float* WGL = (LAS float*)(F.lds + P1_WGL); LAS float* WG2 = (LAS float*)(F.lds + P1_WG2); LAS float* BG = (LAS float*)(F.lds + P1_BG);
    for (int idx = F.tid; idx < 1024 * 16; idx += NWAVES * 64) { const int k = idx >> 4, c = idx & 15; const int j = k >> 8, l = (k >> 2) & 63, e = k & 3;
        WGL[((j * 4 + e) * 64 + l) * 20 + c] = F.w_in[(size_t)k * DIN + C_GLR + c]; }
    for (int idx = F.tid; idx < 16 * 256; idx += NWAVES * 64) WG2[idx] = F.w_gate2[idx];
    for (int idx = F.tid; idx < 256; idx += NWAVES * 64) BG[idx] = F.b_gate[idx];
    __syncthreads();
    const int gw = F.vcu * NWAVES + F.wave, NGW = F.G * NWAVES, lane = F.lane;
    const float* MOD = (const float*)(F.ctl + CW_MOD);
    bf16* XN = WSP(bf16, WS_XN); float* LOGA = WSP(float, WS_LOGA);
    for (int m = gw; m < M; m += NGW) {
        const int b = m >> 13;
        const GAS f32x4* xr = (const GAS f32x4*)(F.x + (size_t)m * DM) + lane;
        f32x4 v[4]; float s = 0.f;
#pragma unroll
        for (int j = 0; j < 4; ++j) { v[j] = xr[64 * j]; s += (v[j].x * v[j].x + v[j].y * v[j].y) + (v[j].z * v[j].z + v[j].w * v[j].w); }
        const float rstd = 1.f / sqrtf(wave_sum(s) * (1.f / DM) + EPS);
        float part[16];
#pragma unroll
        for (int c = 0; c < 16; ++c) part[c] = 0.f;
        GAS v2u* o8 = (GAS v2u*)(XN + (size_t)m * DM) + lane;
#pragma unroll
        for (int j = 0; j < 4; ++j) {
            const f32x4 g = *(const GAS f32x4*)(F.g_pre_mix + 256 * j + 4 * lane);
            const f32x4 sc = *(const GAS f32x4*)(MOD + b * MOD_LD + MOD_SC1 + 256 * j + 4 * lane), sh = *(const GAS f32x4*)(MOD + b * MOD_LD + MOD_SH1 + 256 * j + 4 * lane);
            f32x4 h = v[j] * rstd * g * (sc + 1.f) + sh;
            v2u w; w.x = pk2(h.x, h.y); w.y = pk2(h.z, h.w); o8[64 * j] = w;
#pragma unroll
            for (int e = 0; e < 4; ++e) { const LAS float* wp = WGL + ((j * 4 + e) * 64 + lane) * 20; const float hv = h[e];
#pragma unroll
                for (int c4 = 0; c4 < 4; ++c4) { const f32x4 w4 = *(const LAS f32x4*)(wp + 4 * c4);
                    part[4 * c4 + 0] += hv * w4.x; part[4 * c4 + 1] += hv * w4.y; part[4 * c4 + 2] += hv * w4.z; part[4 * c4 + 3] += hv * w4.w; }
                asm volatile("" ::: "memory"); }
        }
#pragma unroll
        for (int c = 0; c < 16; ++c) part[c] = wave_sum(part[c]);
#pragma unroll
        for (int i = 0; i < 4; ++i) { const int n = lane + 64 * i; float z = BG[n];
#pragma unroll
            for (int c = 0; c < 16; ++c) z += part[c] * WG2[c * 256 + n];
            LOGA[(size_t)m * 256 + n] = log_sigmoid(z) * (1.f / 16.f); }
    }
}
constexpr int GL_HALF = 45056, GL_BC = 0, GL_K = 16384, GL_V = 25600, GL_TOT = 43008, GL_Q = 44032;
constexpr int GL_HALF5 = 53248;
constexpr int KP = 72, VP = 136;
__device__ __forceinline__ void gla_bcum(const float* LOGA, int b, int h, int c, LAS float* bc, LAS float* tot, int tl) {
    const int d = tl & 63, qt = tl >> 6;
    float loc[16]; float run = 0.f;
    const float* src = LOGA + ((size_t)(b * SEQ + c * 64 + qt * 16)) * 256 + h * 64 + d;
#pragma unroll
    for (int i = 0; i < 16; ++i) { run += src[(size_t)i * 256]; loc[i] = run; }
    tot[qt * 64 + d] = run;
    __syncthreads();
    float off = 0.f;
#pragma unroll
    for (int q = 0; q < 3; ++q) if (q < qt) off += tot[q * 64 + d];
#pragma unroll
    for (int i = 0; i < 16; ++i) bc[(qt * 16 + i) * 64 + d] = loc[i] + off;
    __syncthreads();
}
__device__ __forceinline__ void gla_prep_item(Frame& F, int item, LAS unsigned char* L, int tl, int wl, int lane) {
    const int bh = item >> 7, c = item & 127, b = bh >> 2, h = bh & 3;
    LAS float* bc = (LAS float*)(L + GL_BC); LAS float* tot = (LAS float*)(L + GL_TOT);
    LAS bf16* kh = (LAS bf16*)(L + GL_K); LAS bf16* vv = (LAS bf16*)(L + GL_V);
    const bf16* PROJ = WSP(bf16, WS_PROJ);
    gla_bcum(WSP(float, WS_LOGA), b, h, c, bc, tot, tl);
    const size_t row0 = (size_t)b * SEQ + c * 64;
#pragma unroll
    for (int rep = 0; rep < 2; ++rep) { const int p = tl + 256 * rep, i = p >> 3, o = p & 7;
        const v4u kw = *(const GAS v4u*)(PROJ + (row0 + i) * NPROJ + C_GK + h * 64 + 8 * o);
        float f[8];
#pragma unroll
        for (int e = 0; e < 4; ++e) { f[2 * e] = bflo(kw[e]); f[2 * e + 1] = bfhi(kw[e]); }
#pragma unroll
        for (int e = 0; e < 8; ++e) f[e] *= __expf(bc[63 * 64 + 8 * o + e] - bc[i * 64 + 8 * o + e]);
        v4u ow; ow.x = pk2(f[0], f[1]); ow.y = pk2(f[2], f[3]); ow.z = pk2(f[4], f[5]); ow.w = pk2(f[6], f[7]);
        *(LAS v4u*)(kh + i * KP + 8 * o) = ow; }
#pragma unroll
    for (int rep = 0; rep < 4; ++rep) { const int p = tl + 256 * rep, i = p >> 4, o = p & 15;
        *(LAS v4u*)(vv + i * VP + 8 * o) = *(const GAS v4u*)(PROJ + (row0 + i) * NPROJ + C_GV + h * 128 + 8 * o); }
    __syncthreads();
    const int i16 = lane & 15, g = lane >> 4;
    f32x4 acc[2][4];
#pragma unroll
    for (int a = 0; a < 2; ++a)
#pragma unroll
        for (int n = 0; n < 4; ++n) acc[a][n] = (f32x4){0.f, 0.f, 0.f, 0.f};
#pragma unroll
    for (int ks = 0; ks < 2; ++ks) {
        bf16x8 A[2], B[4];
        const int krow = 32 * ks + 8 * g + (i16 >> 2);
#pragma unroll
        for (int a = 0; a < 2; ++a) { const LAS unsigned char* p = (const LAS unsigned char*)(vv + krow * VP + 16 * (2 * wl + a) + 4 * (i16 & 3)); A[a] = cat8(tr16(p), tr16(p + 4 * VP * 2)); }
#pragma unroll
        for (int n = 0; n < 4; ++n) { const LAS unsigned char* p = (const LAS unsigned char*)(kh + krow * KP + 16 * n + 4 * (i16 & 3)); B[n] = cat8(tr16(p), tr16(p + 4 * KP * 2)); }
#pragma unroll
        for (int a = 0; a < 2; ++a)
#pragma unroll
            for (int n = 0; n < 4; ++n) acc[a][n] = mfma16(A[a], B[n], acc[a][n]);
    }
    float* UT = WSP(float, WS_UT) + (size_t)(bh * 128 + c) * 8192;
#pragma unroll
    for (int a = 0; a < 2; ++a)
#pragma unroll
        for (int n = 0; n < 4; ++n)
#pragma unroll
            for (int r = 0; r < 4; ++r) UT[(16 * (2 * wl + a) + 4 * g + r) * 64 + 16 * n + i16] = acc[a][n][r];
    if (tl < 64) WSP(float, WS_DEC)[(size_t)(bh * 128 + c) * 64 + tl] = __expf(bc[63 * 64 + tl]);
    __syncthreads();
}
__device__ __forceinline__ void gla_scan(Frame& F) {
    if (F.tid >= 256) return;
    float* UT = WSP(float, WS_UT); const float* DEC = WSP(float, WS_DEC);
    for (int blk = F.vcu; blk < 256; blk += F.G) {
        const int bh = blk >> 5, e = (blk & 31) * 4 + (F.tid >> 6), d = F.tid & 63;
        float* p = UT + (size_t)bh * 128 * 8192 + e * 64 + d; const float* dc = DEC + (size_t)bh * 128 * 64 + d;
        float S = 0.f;
        for (int c0 = 0; c0 < 128; c0 += 8) {
            float u[8], a[8];
#pragma unroll
            for (int j = 0; j < 8; ++j) { u[j] = p[(size_t)(c0 + j) * 8192]; a[j] = dc[(c0 + j) * 64]; }
#pragma unroll
            for (int j = 0; j < 8; ++j) { p[(size_t)(c0 + j) * 8192] = S; S = a[j] * S + u[j]; }
        }
    }
}
__device__ __forceinline__ void gla_out_item(Frame& F, int item, LAS unsigned char* L, int tl, int wl, int lane) {
    const int bh = item >> 7, c = item & 127, b = bh >> 2, h = bh & 3;
    LAS float* bc = (LAS float*)(L + GL_BC); LAS float* tot = (LAS float*)(L + GL_TOT);
    LAS bf16* kt = (LAS bf16*)(L + GL_K); LAS bf16* vv = (LAS bf16*)(L + GL_V); LAS bf16* qs = (LAS bf16*)(L + GL_Q);
    const bf16* PROJ = WSP(bf16, WS_PROJ);
    gla_bcum(WSP(float, WS_LOGA), b, h, c, bc, tot, tl);
    const size_t row0 = (size_t)b * SEQ + c * 64;
#pragma unroll
    for (int rep = 0; rep < 2; ++rep) { const int p = tl + 256 * rep, i = p >> 3, o = p & 7;
        const v4u kw = *(const GAS v4u*)(PROJ + (row0 + i) * NPROJ + C_GK + h * 64 + 8 * o);
        const v4u qw = *(const GAS v4u*)(PROJ + (row0 + i) * NPROJ + C_GQ + h * 64 + 8 * o);
        float fk[8], fq[8];
#pragma unroll
        for (int e = 0; e < 4; ++e) { fk[2 * e] = bflo(kw[e]); fk[2 * e + 1] = bfhi(kw[e]); fq[2 * e] = bflo(qw[e]); fq[2 * e + 1] = bfhi(qw[e]); }
#pragma unroll
        for (int e = 0; e < 8; ++e) { const float bb = bc[i * 64 + 8 * o + e]; fk[e] *= __expf(-bb); fq[e] *= __expf(bb); }
        v4u ow; ow.x = pk2(fk[0], fk[1]); ow.y = pk2(fk[2], fk[3]); ow.z = pk2(fk[4], fk[5]); ow.w = pk2(fk[6], fk[7]);
        *(LAS v4u*)(kt + i * KP + 8 * o) = ow;
        ow.x = pk2(fq[0], fq[1]); ow.y = pk2(fq[2], fq[3]); ow.z = pk2(fq[4], fq[5]); ow.w = pk2(fq[6], fq[7]);
        *(LAS v4u*)(qs + i * KP + 8 * o) = ow; }
#pragma unroll
    for (int rep = 0; rep < 4; ++rep) { const int p = tl + 256 * rep, i = p >> 4, o = p & 15;
        *(LAS v4u*)(vv + i * VP + 8 * o) = *(const GAS v4u*)(PROJ + (row0 + i) * NPROJ + C_GV + h * 128 + 8 * o); }
    __syncthreads();
    const int i16 = lane & 15, g = lane >> 4;
    const int itok = 16 * wl + i16;
    bf16x8 Bq[2];
#pragma unroll
    for (int ks = 0; ks < 2; ++ks) Bq[ks] = *(const LAS bf16x8*)(qs + itok * KP + 32 * ks + 8 * g);
    bf16x8 Pf[2];
#pragma unroll
    for (int jp = 0; jp < 2; ++jp) {
        const int ja = 32 * jp + 8 * (i16 >> 2) + (i16 & 3), jb = ja + 4;
        f32x4 sa = {0.f, 0.f, 0.f, 0.f}, sb = {0.f, 0.f, 0.f, 0.f};
#pragma unroll
        for (int ks = 0; ks < 2; ++ks) {
            const bf16x8 Aa = *(const LAS bf16x8*)(kt + ja * KP + 32 * ks + 8 * g), Ab = *(const LAS bf16x8*)(kt + jb * KP + 32 * ks + 8 * g);
            sa = mfma16(Aa, Bq[ks], sa); sb = mfma16(Ab, Bq[ks], sb); }
#pragma unroll
        for (int r = 0; r < 4; ++r) { const int j = 32 * jp + 8 * g + r; sa[r] = (j <= itok) ? sa[r] : 0.f; sb[r] = (j + 4 <= itok) ? sb[r] : 0.f; }
        Pf[jp] = pack8(sa, sb);
    }
    f32x4 acc[8];
    const float* ST = WSP(float, WS_UT) + (size_t)(bh * 128 + c) * 8192;
#pragma unroll
    for (int mt = 0; mt < 8; ++mt) {
        f32x4 a = {0.f, 0.f, 0.f, 0.f};
#pragma unroll
        for (int jp = 0; jp < 2; ++jp) { const LAS unsigned char* p = (const LAS unsigned char*)(vv + (32 * jp + 8 * g + (i16 >> 2)) * VP + 16 * mt + 4 * (i16 & 3));
            a = mfma16(cat8(tr16(p), tr16(p + 4 * VP * 2)), Pf[jp], a); }
#pragma unroll
        for (int ks = 0; ks < 2; ++ks) { const float* sp = ST + (16 * mt + i16) * 64 + 32 * ks + 8 * g;
            const f32x4 s0 = *(const GAS f32x4*)sp, s1 = *(const GAS f32x4*)(sp + 4);
            a = mfma16(pack8(s0, s1), Bq[ks], a); }
        acc[mt] = a;
    }
    float ss = 0.f;
#pragma unroll
    for (int mt = 0; mt < 8; ++mt) ss += (acc[mt][0] * acc[mt][0] + acc[mt][1] * acc[mt][1]) + (acc[mt][2] * acc[mt][2] + acc[mt][3] * acc[mt][3]);
    ss += __shfl_xor(ss, 16); ss += __shfl_xor(ss, 32);
    const float rstd = 1.f / sqrtf(ss * (1.f / 128.f) + EPS);
    const size_t trow = row0 + itok;
    bf16* MIX = WSP(bf16, WS_XN);
#pragma unroll
    for (int mt = 0; mt < 8; ++mt) { const int e0 = 16 * mt + 4 * g;
        const f32x4 gg = *(const GAS f32x4*)(F.g_gla + e0);
        const v2u gw2 = *(const GAS v2u*)(PROJ + trow * NPROJ + C_GR + h * 128 + e0);
        float gr[4] = {bflo(gw2.x), bfhi(gw2.x), bflo(gw2.y), bfhi(gw2.y)}; float o[4];
#pragma unroll
        for (int r = 0; r < 4; ++r) o[r] = acc[mt][r] * rstd * gg[r] * (gr[r] / (1.f + __expf(-gr[r])));
        v2u w; w.x = pk2(o[0], o[1]); w.y = pk2(o[2], o[3]);
        *(GAS v2u*)(MIX + trow * DM + 512 + h * 128 + e0) = w; }
    __syncthreads();
}

constexpr int AT_BIAS = 0, AT_VST = 16384, BIAS_LD = 132;
template <int D>
__device__ __forceinline__ void attn_pattern(const bf16* Kb, const bf16* Vb, int tq0, const LAS float* bias, LAS unsigned char* vst,
                                             const bf16x8 (&qf)[2], float& Mrun, float& Lrun, f32x4 (&O)[4], int lane, int ns, int kofs) {
    constexpr int QS = 16 / D;
    const int i16 = lane & 15, g = lane >> 4;
    const int r = tq0 & (D - 1), lqb = tq0 / D, lq = lqb + QS * i16, lk0 = lqb + QS * 15 - kofs;
    bf16x8 kc[4], kn[4]; v4u vr[4], vn[4];
#define AT_KLOAD(dst, s_) do { const int ka_ = lk0 + 32 * (s_) + 8 * (i16 >> 2) + (i16 & 3), kb_ = ka_ + 4; \
        const int ta_ = (ka_ < 0 ? 0 : ka_) * D + r, tb_ = (kb_ < 0 ? 0 : kb_) * D + r; \
        const bf16* pa_ = Kb + (size_t)ta_ * NPROJ + 8 * g; const bf16* pb_ = Kb + (size_t)tb_ * NPROJ + 8 * g; \
        dst[0] = *(const GAS bf16x8*)pa_; dst[1] = *(const GAS bf16x8*)(pa_ + 32); dst[2] = *(const GAS bf16x8*)pb_; dst[3] = *(const GAS bf16x8*)(pb_ + 32); } while (0)
#define AT_VLOAD(dst, s_) do { _Pragma("unroll") for (int ii = 0; ii < 4; ++ii) { int lk_ = lk0 + 32 * (s_) + 8 * ii + (lane >> 3); lk_ = lk_ < 0 ? 0 : lk_; \
        dst[ii] = *(const GAS v4u*)(Vb + (size_t)(lk_ * D + r) * NPROJ + (lane & 7) * 8); } } while (0)
    AT_KLOAD(kc, 0); AT_VLOAD(vr, 0);
#pragma unroll 1
    for (int s = 0; s < ns; ++s) {
        const int sn = (s + 1 < ns) ? s + 1 : s;
        AT_KLOAD(kn, sn); AT_VLOAD(vn, sn);
        const f32x4 z = {0.f, 0.f, 0.f, 0.f};
        f32x4 sa = mfma16(kc[1], qf[1], mfma16(kc[0], qf[0], z));
        f32x4 sb = mfma16(kc[3], qf[1], mfma16(kc[2], qf[0], z));
        float mx = -1e30f;
#pragma unroll
        for (int e = 0; e < 4; ++e) {
            { const int lk = lk0 + 32 * s + 8 * g + e, rel = lq - lk; const bool ok = (rel >= 0) & (rel <= 128) & (lk >= 0);
              const float bv = bias[min(max(rel, 0), 128)]; const float v = (sa[e] + bv) + (ok ? 0.f : -1e30f); sa[e] = v; mx = fmaxf(mx, v); }
            { const int lk = lk0 + 32 * s + 8 * g + 4 + e, rel = lq - lk; const bool ok = (rel >= 0) & (rel <= 128) & (lk >= 0);
              const float bv = bias[min(max(rel, 0), 128)]; const float v = (sb[e] + bv) + (ok ? 0.f : -1e30f); sb[e] = v; mx = fmaxf(mx, v); }
        }
        mx = fmaxf(mx, __shfl_xor(mx, 16)); mx = fmaxf(mx, __shfl_xor(mx, 32));
        const float Mnew = fmaxf(Mrun, mx), alpha = __builtin_amdgcn_exp2f(Mrun - Mnew);
        Mrun = Mnew;
        float ls = 0.f;
#pragma unroll
        for (int e = 0; e < 4; ++e) { sa[e] = __builtin_amdgcn_exp2f(sa[e] - Mnew); sb[e] = __builtin_amdgcn_exp2f(sb[e] - Mnew); ls += sa[e] + sb[e]; }
        Lrun = Lrun * alpha + ls;
        const bf16x8 pf = pack8(sa, sb);
#pragma unroll
        for (int ii = 0; ii < 4; ++ii) *(LAS v4u*)(vst + (8 * ii + (lane >> 3)) * 128 + (lane & 7) * 16) = vr[ii];
#pragma unroll
        for (int mt = 0; mt < 4; ++mt) { const LAS unsigned char* p = vst + (8 * g + (i16 >> 2)) * 128 + (16 * mt + 4 * (i16 & 3)) * 2;
            O[mt] = mfma16(cat8(tr16(p), tr16(p + 512)), pf, O[mt] * alpha); }
#pragma unroll
        for (int q = 0; q < 4; ++q) { kc[q] = kn[q]; vr[q] = vn[q]; }
    }
#undef AT_KLOAD
#undef AT_VLOAD
}
__device__ __forceinline__ void attn_item(Frame& F, int it, LAS unsigned char* vst, const LAS float* biasT, int lane) {
    const int rho = it & 15, tile = (it >> 4) & 31, h = (it >> 9) & 7, b = it >> 12;
    const int tq0 = tile * 256 + rho, i16 = lane & 15, g = lane >> 4;
    const bf16* PROJ = WSP(bf16, WS_PROJ) + (size_t)b * SEQ * NPROJ;
    const bf16* qp = PROJ + (size_t)(tq0 + 16 * i16) * NPROJ + C_AQ + h * 64 + 8 * g;
    bf16x8 qf[2]; qf[0] = *(const GAS bf16x8*)qp; qf[1] = *(const GAS bf16x8*)(qp + 32);
    float Mrun = -1e30f, Lrun = 0.f; f32x4 O[4];
#pragma unroll
    for (int mt = 0; mt < 4; ++mt) O[mt] = (f32x4){0.f, 0.f, 0.f, 0.f};
    const bf16* Kb = PROJ + C_AK + h * 64; const bf16* Vb = PROJ + C_AV + h * 64;
    attn_pattern<1>(Kb, Vb, tq0, biasT + (0 * 8 + h) * BIAS_LD, vst, qf, Mrun, Lrun, O, lane, 12, 383);
    attn_pattern<4>(Kb, Vb, tq0, biasT + (1 * 8 + h) * BIAS_LD, vst, qf, Mrun, Lrun, O, lane, 6, 191);
    attn_pattern<16>(Kb, Vb, tq0, biasT + (2 * 8 + h) * BIAS_LD, vst, qf, Mrun, Lrun, O, lane, 5, 159);
    float L = Lrun; L += __shfl_xor(L, 16); L += __shfl_xor(L, 32);
    const float inv = 1.f / L;
    bf16* MIX = WSP(bf16, WS_XN) + ((size_t)b * SEQ + tq0 + 16 * i16) * DM + h * 64;
#pragma unroll
    for (int mt = 0; mt < 4; ++mt) { v2u w; w.x = pk2(O[mt][0] * inv, O[mt][1] * inv); w.y = pk2(O[mt][2] * inv, O[mt][3] * inv); *(GAS v2u*)(MIX + 16 * mt + 4 * g) = w; }
}
__device__ __forceinline__ int t5_bucket(int dist) {
    if (dist < 16) return dist;
    return 16 + (dist >= 22) + (dist >= 30) + (dist >= 40) + (dist >= 54) + (dist >= 73) + (dist >= 99) + (dist >= 134) + (dist >= 182) + (dist >= 246)
              + (dist >= 332) + (dist >= 450) + (dist >= 609) + (dist >= 825) + (dist >= 1117) + (dist >= 1513);
}
__device__ __forceinline__ void p3_attn_and_gla_prep(Frame& F) {
#ifndef NO_GLAPREP
    { const int half = F.wave >> 2, tl = F.tid & 255, wl = F.wave & 3; LAS unsigned char* L = F.lds + RING_OFF + half * GL_HALF;
      const int nh = F.G * 2;
      for (int base = 0; base < 1024; base += nh) { int item = base + F.vcu * 2 + half; item = item > 1023 ? 1023 : item; gla_prep_item(F, item, L, tl, wl, F.lane); }
    }
#endif
    __syncthreads();
    LAS float* biasT = (LAS float*)(F.lds + RING_OFF + AT_BIAS);
    for (int idx = F.tid; idx < 3 * 8 * 129; idx += NWAVES * 64) { const int p = idx / (8 * 129), rem = idx % (8 * 129), h = rem / 129, rel = rem % 129;
        const int dil = p == 0 ? 1 : (p == 1 ? 4 : 16);
        biasT[(p * 8 + h) * BIAS_LD + rel] = F.rel_bias[t5_bucket(rel * dil) * 8 + h] * LOG2E; }
    __syncthreads();
    LAS unsigned char* vst = F.lds + RING_OFF + AT_VST + F.wave * 4096;
    const int gw = F.vcu * NWAVES + F.wave, NGW = F.G * NWAVES;
#ifndef NO_ATTN
    for (int it = gw; it < 2 * 8 * 32 * 16; it += NGW) attn_item(F, it, vst, biasT, F.lane);
#endif
}
__device__ __forceinline__ void p5_gla_out(Frame& F) {
    const int half = F.wave >> 2, tl = F.tid & 255, wl = F.wave & 3; LAS unsigned char* L = F.lds + RING_OFF + half * GL_HALF5;
    const int nh = F.G * 2;
    for (int base = 0; base < 1024; base += nh) { int item = base + F.vcu * 2 + half; item = item > 1023 ? 1023 : item; gla_out_item(F, item, L, tl, wl, F.lane); }
}
__device__ __forceinline__ void p7_postmix(Frame& F) {
    const int gw = F.vcu * NWAVES + F.wave, NGW = F.G * NWAVES, lane = F.lane;
    const float* MOD = (const float*)(F.ctl + CW_MOD); const float* Y1 = WSP(float, WS_PROJ); bf16* XN = WSP(bf16, WS_XN);
    for (int m = gw; m < M; m += NGW) {
        const int b = m >> 13;
        const GAS f32x4* yr = (const GAS f32x4*)(Y1 + (size_t)m * DM) + lane; const GAS f32x4* xr = (const GAS f32x4*)(F.x + (size_t)m * DM) + lane;
        f32x4 y[4], xv[4]; float s = 0.f;
#pragma unroll
        for (int j = 0; j < 4; ++j) { y[j] = yr[64 * j]; xv[j] = xr[64 * j]; s += (y[j].x * y[j].x + y[j].y * y[j].y) + (y[j].z * y[j].z + y[j].w * y[j].w); }
        const float rstd = 1.f / sqrtf(wave_sum(s) * (1.f / DM) + EPS);
        float s1 = 0.f;
        GAS f32x4* orow = (GAS f32x4*)(F.out + (size_t)m * DM) + lane;
#pragma unroll
        for (int j = 0; j < 4; ++j) { const int col = 256 * j + 4 * lane;
            const f32x4 gp = *(const GAS f32x4*)(F.g_post_mix + col), ga = *(const GAS f32x4*)(MOD + b * MOD_LD + MOD_GA1 + col);
            xv[j] = xv[j] + ga * (y[j] * rstd * gp); orow[64 * j] = xv[j];
            s1 += (xv[j].x * xv[j].x + xv[j].y * xv[j].y) + (xv[j].z * xv[j].z + xv[j].w * xv[j].w); }
        const float rstd1 = 1.f / sqrtf(wave_sum(s1) * (1.f / DM) + EPS);
        GAS v2u* o8 = (GAS v2u*)(XN + (size_t)m * DM) + lane;
#pragma unroll
        for (int j = 0; j < 4; ++j) { const int col = 256 * j + 4 * lane;
            const f32x4 g = *(const GAS f32x4*)(F.g_pre_ffn + col), sc = *(const GAS f32x4*)(MOD + b * MOD_LD + MOD_SC2 + col), sh = *(const GAS f32x4*)(MOD + b * MOD_LD + MOD_SH2 + col);
            const f32x4 h = xv[j] * rstd1 * g * (sc + 1.f) + sh;
            v2u w; w.x = pk2(h.x, h.y); w.y = pk2(h.z, h.w); o8[64 * j] = w; }
    }
}

__device__ __forceinline__ unsigned umax_(unsigned a, unsigned b) { return a > b ? a : b; }
__device__ __forceinline__ unsigned umin_(unsigned a, unsigned b) { return a < b ? a : b; }
template <int N> __device__ __forceinline__ void bitonic_sort_desc(unsigned (&x)[N]) {
#pragma unroll
    for (int k = 2; k <= N; k <<= 1)
#pragma unroll
        for (int j = k >> 1; j > 0; j >>= 1)
#pragma unroll
            for (int i = 0; i < N; ++i) { const int l = i ^ j; if (l > i) { const unsigned a = x[i], b = x[l]; const bool desc = ((i & k) == 0);
                x[i] = desc ? umax_(a, b) : umin_(a, b); x[l] = desc ? umin_(a, b) : umax_(a, b); } }
}
__device__ __forceinline__ void merge16(unsigned (&a)[16], const unsigned (&b)[16]) {
#pragma unroll
    for (int i = 0; i < 16; ++i) a[i] = umax_(a[i], b[15 - i]);
#pragma unroll
    for (int j = 8; j > 0; j >>= 1)
#pragma unroll
        for (int i = 0; i < 16; ++i) { const int l = i ^ j; if (l > i) { const unsigned hi = umax_(a[i], a[l]), lo = umin_(a[i], a[l]); a[i] = hi; a[l] = lo; } }
}
__device__ __forceinline__ void p9_item(Frame& F, int it, int lane) {
    const int head = it & 7, tile = it >> 3, i16 = lane & 15, g = lane >> 4, tok = tile * 16 + i16;
    const bf16* Q = WSP(bf16, WS_PROJ) + (size_t)tok * PQD + head * 256;
    const bf16* SK = WSP(bf16, WS_SUBK) + (size_t)head * 2 * 128 * 128;
    unsigned top[2][16];
#pragma unroll
    for (int p = 0; p < 2; ++p) {
        bf16x8 Bq[4];
#pragma unroll
        for (int ks = 0; ks < 4; ++ks) Bq[ks] = *(const GAS bf16x8*)(Q + p * 128 + 32 * ks + 8 * g);
        unsigned lo[16], hi[16];
#pragma unroll
        for (int kt = 0; kt < 8; ++kt) {
            f32x4 acc = {0.f, 0.f, 0.f, 0.f};
            const bf16* ap = SK + (size_t)(p * 128 + 16 * kt + i16) * 128 + 8 * g;
#pragma unroll
            for (int ks = 0; ks < 4; ++ks) acc = mfma16(*(const GAS bf16x8*)(ap + 32 * ks), Bq[ks], acc);
#pragma unroll
            for (int r = 0; r < 4; ++r) { const int key = 16 * kt + 4 * g + r; float f = (acc[r] + 16.f) * 1048576.f; f = fminf(fmaxf(f, 0.f), 33554431.f);
                const unsigned pk = ((unsigned)f << 7) | (unsigned)(127 - key);
                if (kt < 4) lo[4 * kt + r] = pk; else hi[4 * (kt - 4) + r] = pk; }
        }
        bitonic_sort_desc<16>(lo); bitonic_sort_desc<16>(hi); merge16(lo, hi);
#pragma unroll
        for (int xr = 16; xr <= 32; xr <<= 1) {
#pragma unroll
            for (int i = 0; i < 16; ++i) hi[i] = (unsigned)__shfl_xor((int)lo[i], xr);
            merge16(lo, hi); }
#pragma unroll
        for (int i = 0; i < 16; ++i) top[p][i] = lo[i];
    }
    unsigned c[4][16];
#pragma unroll
    for (int q = 0; q < 4; ++q)
#pragma unroll
        for (int i = 0; i < 16; ++i) c[q][i] = 0u;
    {
        int n = 0;
#pragma unroll
        for (int i = 0; i < 16; ++i)
#pragma unroll
            for (int j = 0; j < 16; ++j) if ((i + 1) * (j + 1) <= 16) {
                const unsigned A = top[0][i], B = top[1][j];
                const unsigned ex = (127u - (A & 127u)) * 128u + (127u - (B & 127u));
                c[n >> 4][n & 15] = ((((A >> 7) + (B >> 7)) >> 8) << 14) | ex; ++n; }
    }
    bitonic_sort_desc<16>(c[0]); bitonic_sort_desc<16>(c[1]); bitonic_sort_desc<16>(c[2]); bitonic_sort_desc<16>(c[3]);
    merge16(c[0], c[1]); merge16(c[2], c[3]); merge16(c[0], c[2]);
    float ev[16]; float sum = 0.f;
    const float f0 = (float)(c[0][0] >> 14);
#pragma unroll
    for (int k = 0; k < 16; ++k) { ev[k] = __expf(((float)(c[0][k] >> 14) - f0) * (1.f / 4096.f)); sum += ev[k]; }
    const float inv = 1.f / sum;
    int* EIDX = WSP(int, WS_EIDX) + (size_t)tok * 128 + head * 16; float* GATE = WSP(float, WS_GATE) + (size_t)tok * 128 + head * 16;
#pragma unroll
    for (int k = 0; k < 16; ++k) if (g == (k >> 2)) { EIDX[k] = (int)(c[0][k] & 16383u); GATE[k] = ev[k] * inv; }
}
__device__ __forceinline__ void p9_topk(Frame& F) {
    const int gw = F.vcu * NWAVES + F.wave, NGW = F.G * NWAVES;
    for (int it = gw; it < (M / 16) * 8; it += NGW) p9_item(F, it, F.lane);
}

__device__ __forceinline__ float gelu_erf(float s) { return 0.5f * s * (1.f + erff(s * 0.70710678118654752f)); }
__device__ __forceinline__ float xreduce16(float (&v)[16], int c) {
    float w8[8], w4[4], w2[2];
    const bool b3 = (c & 8) != 0, b2 = (c & 4) != 0, b1 = (c & 2) != 0, b0 = (c & 1) != 0;
#pragma unroll
    for (int i = 0; i < 8; ++i) { const float keep = b3 ? v[i + 8] : v[i], give = b3 ? v[i] : v[i + 8]; w8[i] = keep + __shfl_xor(give, 8); }
#pragma unroll
    for (int i = 0; i < 4; ++i) { const float keep = b2 ? w8[i + 4] : w8[i], give = b2 ? w8[i] : w8[i + 4]; w4[i] = keep + __shfl_xor(give, 4); }
#pragma unroll
    for (int i = 0; i < 2; ++i) { const float keep = b1 ? w4[i + 2] : w4[i], give = b1 ? w4[i] : w4[i + 2]; w2[i] = keep + __shfl_xor(give, 2); }
    const float keep = b0 ? w2[1] : w2[0], give = b0 ? w2[0] : w2[1];
    return keep + __shfl_xor(give, 1);
}
__device__ __forceinline__ void p10_peer_u(Frame& F) {
    const int lane = F.lane, r = lane >> 4, c = lane & 15;
    const int sl = (int)blockIdx.x & 7, rank = (int)blockIdx.x >> 3, nrank = F.G >> 3;
    const bf16* XN = WSP(bf16, WS_XN); const bf16* US = WSP(bf16, WS_U16) + (size_t)sl * NEXP * 128 + 8 * c;
    const int* EIDX = WSP(int, WS_EIDX); float* PART = WSP(float, WS_PART) + (size_t)sl * M * 128;
    for (int tok = rank * NWAVES + F.wave; tok < M; tok += nrank * NWAVES) {
        const v4u hq = *(const GAS v4u*)(XN + (size_t)tok * DM + 128 * sl + 8 * c);
        const int e0 = EIDX[(size_t)tok * 128 + lane], e1 = EIDX[(size_t)tok * 128 + 64 + lane];
#pragma unroll
        for (int hf = 0; hf < 2; ++hf) {
            float pv[16];
#pragma unroll
            for (int j = 0; j < 16; ++j) {
                const int e = __shfl(hf == 0 ? e0 : e1, 4 * j + r);
                const v4u a = *(const GAS v4u*)(US + (size_t)e * 128);
                pv[j] = dot2bf(a.w, hq.w, dot2bf(a.z, hq.z, dot2bf(a.y, hq.y, dot2bf(a.x, hq.x, 0.f))));
            }
            const float tot = xreduce16(pv, c);
            PART[(size_t)tok * 128 + 64 * hf + 4 * c + r] = tot;
        }
    }
}
__device__ __forceinline__ void p11_peer_v(Frame& F) {
    const int lane = F.lane, r = lane >> 4, c = lane & 15;
    const int sl = (int)blockIdx.x & 7, rank = (int)blockIdx.x >> 3, nrank = F.G >> 3;
    const bf16* VS = WSP(bf16, WS_V16) + (size_t)sl * NEXP * 128 + 8 * c;
    const int* EIDX = WSP(int, WS_EIDX); const float* GATE = WSP(float, WS_GATE); const float* PART = WSP(float, WS_PART); float* Y2 = WSP(float, WS_Y2);
    for (int tok = rank * NWAVES + F.wave; tok < M; tok += nrank * NWAVES) {
        const int e0 = EIDX[(size_t)tok * 128 + lane], e1 = EIDX[(size_t)tok * 128 + 64 + lane];
        float a0 = 0.f, a1 = 0.f;
#pragma unroll
        for (int q = 0; q < 8; ++q) { a0 += PART[((size_t)q * M + tok) * 128 + lane]; a1 += PART[((size_t)q * M + tok) * 128 + 64 + lane]; }
        const float w0 = GATE[(size_t)tok * 128 + lane] * gelu_erf(a0), w1 = GATE[(size_t)tok * 128 + 64 + lane] * gelu_erf(a1);
        float acc[8];
#pragma unroll
        for (int i = 0; i < 8; ++i) acc[i] = 0.f;
#pragma unroll
        for (int hf = 0; hf < 2; ++hf)
#pragma unroll 8
            for (int j = 0; j < 16; ++j) {
                const int e = __shfl(hf == 0 ? e0 : e1, 4 * j + r); const float w = __shfl(hf == 0 ? w0 : w1, 4 * j + r);
                const v4u a = *(const GAS v4u*)(VS + (size_t)e * 128);
#pragma unroll
                for (int i = 0; i < 4; ++i) { acc[2 * i] += w * bflo(a[i]); acc[2 * i + 1] += w * bfhi(a[i]); }
            }
#pragma unroll
        for (int i = 0; i < 8; ++i) { acc[i] += __shfl_xor(acc[i], 16); acc[i] += __shfl_xor(acc[i], 32); }
        if (r == 0) { float* yp = Y2 + (size_t)tok * DM + 128 * sl + 8 * c;
            *(GAS f32x4*)yp = (f32x4){acc[0], acc[1], acc[2], acc[3]}; *(GAS f32x4*)(yp + 4) = (f32x4){acc[4], acc[5], acc[6], acc[7]}; }
    }
}
__device__ __forceinline__ void p12_final(Frame& F) {
    const int gw = F.vcu * NWAVES + F.wave, NGW = F.G * NWAVES, lane = F.lane;
    const float* MOD = (const float*)(F.ctl + CW_MOD); const float* Y2 = WSP(float, WS_Y2);
    for (int m = gw; m < M; m += NGW) {
        const int b = m >> 13;
        const GAS f32x4* yr = (const GAS f32x4*)(Y2 + (size_t)m * DM) + lane; GAS f32x4* orow = (GAS f32x4*)(F.out + (size_t)m * DM) + lane;
        f32x4 y[4], xv[4]; float s = 0.f;
#pragma unroll
        for (int j = 0; j < 4; ++j) { y[j] = yr[64 * j]; xv[j] = orow[64 * j]; s += (y[j].x * y[j].x + y[j].y * y[j].y) + (y[j].z * y[j].z + y[j].w * y[j].w); }
        const float rstd = 1.f / sqrtf(wave_sum(s) * (1.f / DM) + EPS);
#pragma unroll
        for (int j = 0; j < 4; ++j) { const int col = 256 * j + 4 * lane;
            const f32x4 gp = *(const GAS f32x4*)(F.g_post_ffn + col), ga = *(const GAS f32x4*)(MOD + b * MOD_LD + MOD_GA2 + col);
            orow[64 * j] = xv[j] + ga * (y[j] * rstd * gp); }
    }
}

struct Args { const float* in[18]; float* out; unsigned char* ws; int ph_lo, ph_hi, li, pad; };
__global__ void __launch_bounds__(NWAVES * 64, 2) hyb_fwd(Args args) {
    extern __shared__ __attribute__((aligned(16))) unsigned char lds[];
    Frame F;
    F.lds = (LAS unsigned char*)lds;
    F.MISC = (volatile LAS unsigned*)(F.lds + MISC_OFF);
    F.tid = threadIdx.x; F.lane = F.tid & 63; F.wave = __builtin_amdgcn_readfirstlane(F.tid >> 6);
    F.G = gridDim.x; { const int bx = blockIdx.x; F.vcu = (F.G % 8 == 0) ? (bx % 8) * (F.G / 8) + bx / 8 : bx; }
    F.ws = args.ws; F.ctl = (gu32*)(args.ws + WS_CTL); F.out = args.out;
    F.x = args.in[0]; F.c = args.in[1]; F.w_ada = args.in[2]; F.b_ada = args.in[3]; F.g_pre_mix = args.in[4]; F.g_post_mix = args.in[5]; F.w_in = args.in[6];
    F.w_gate2 = args.in[7]; F.b_gate = args.in[8]; F.g_gla = args.in[9]; F.rel_bias = args.in[10]; F.w_out = args.in[11]; F.g_pre_ffn = args.in[12]; F.g_post_ffn = args.in[13];
    F.w_pq = args.in[14]; F.sub_keys = args.in[15]; F.peer_u = args.in[16]; F.peer_v = args.in[17];
    for (int u = F.tid; u < (LDS_BYTES - LDSCTL_OFF) / 4; u += NWAVES * 64) ((LAS unsigned*)(F.lds + LDSCTL_OFF))[u] = 0u;
    __syncthreads();
    const int lo = args.ph_lo, hi = args.ph_hi;
    const bool one = (hi - lo) > 1;
    XcdBarrier bar; bar.bar = (unsigned*)(F.ctl + CW_BAR); bar.x = 0; bar.st = nullptr;
    if (one) bar = xcd_barrier_post((unsigned*)(F.ctl + CW_BAR), F.MISC + 8);
#ifndef PH_MASK
#define PH_MASK 0x1fff
#endif
#define IN(k) (((PH_MASK >> (k)) & 1) && lo <= (k) && (k) < hi)
#define SEAM(k) do { if (IN(k) && IN((k) + 1)) xcd_barrier(bar); } while (0)
#ifndef REP_MASK
#define REP_MASK 0
#endif
#define REPS(k) (1 + ((REP_MASK >> (k)) & 1))
    if (IN(0)) { for (int rp = 0; rp < REPS(0); ++rp) { p0_prologue(F); SEAM(0); } }
    if (IN(1)) { for (int rp = 0; rp < REPS(1); ++rp) { p1_modulate(F); SEAM(1); } }
    if (IN(2)) for (int rp = 0; rp < REPS(2); ++rp) {
        pg8::Gemm g{WSP(bf16, WS_XN), WSP(bf16, WS_WIN), M, NPROJ, DM}; pg8::StaticOrder S; S.init(M, NPROJ, F.G, (int)blockIdx.x);
        pg8::EpiProj E{WSP(bf16, WS_PROJ), NPROJ, 0, C2, 0.125f};
        pg8::gemm_phase<pg8::EpiProj, pg8::StaticOrder, PG8_ALIGN, PG8_SP2>(F.lds + RING_OFF, g, S, E);
        SEAM(2);
    }
    if (IN(3)) { for (int rp = 0; rp < REPS(3); ++rp) { p3_attn_and_gla_prep(F); SEAM(3); } }
    if (IN(4)) { gla_scan(F); SEAM(4); }
    if (IN(5)) { for (int rp = 0; rp < REPS(5); ++rp) { p5_gla_out(F); SEAM(5); } }
    if (IN(6)) for (int rp = 0; rp < REPS(6); ++rp) {
        pg8::Gemm g{WSP(bf16, WS_XN), WSP(bf16, WS_WOUT), M, DM, DM}; pg8::StaticOrder S; S.init(M, DM, F.G, (int)blockIdx.x);
        pg8::EpiF32 E{WSP(float, WS_PROJ), DM};
        pg8::gemm_phase<pg8::EpiF32, pg8::StaticOrder, PG8_ALIGN, PG8_SP2>(F.lds + RING_OFF, g, S, E);
        SEAM(6);
    }
    if (IN(7)) { for (int rp = 0; rp < REPS(7); ++rp) { p7_postmix(F); SEAM(7); } }
    if (IN(8)) for (int rp = 0; rp < REPS(8); ++rp) {
        pg8::Gemm g{WSP(bf16, WS_XN), WSP(bf16, WS_WPQ), M, PQD, DM}; pg8::StaticOrder S; S.init(M, PQD, F.G, (int)blockIdx.x);
        pg8::EpiProj E{WSP(bf16, WS_PROJ), PQD, 1, 1.f, 1.f};
        pg8::gemm_phase<pg8::EpiProj, pg8::StaticOrder, PG8_ALIGN, PG8_SP2>(F.lds + RING_OFF, g, S, E);
        SEAM(8);
    }
    if (IN(9)) { for (int rp = 0; rp < REPS(9); ++rp) { p9_topk(F); SEAM(9); } }
    if (IN(10)) { p10_peer_u(F); SEAM(10); }
    if (IN(11)) { p11_peer_v(F); SEAM(11); }
    if (IN(12)) { p12_final(F); }
#undef IN
#undef SEAM
}

extern "C" void kernel_launch(void* const* d_in, const int* in_sizes, int n_in, void* d_out, int out_size, void* d_ws, size_t ws_size, hipStream_t stream) {
    static int grid = 0;
    if (grid == 0) {
        if (n_in != 18 || in_sizes[0] != M * DM || out_size != M * DM || ws_size < WS_END) { fprintf(stderr, "kernel_launch: unexpected shapes (n_in %d, in0 %d, out %d, ws %zu); nothing launched\n", n_in, n_in > 0 ? in_sizes[0] : -1, out_size, ws_size); grid = -1; return; }
        int dev = 0, cus = 0, per_cu = 0;
        if (hipGetDevice(&dev) != hipSuccess || hipDeviceGetAttribute(&cus, hipDeviceAttributeMultiprocessorCount, dev) != hipSuccess) { grid = -1; return; }
        if (hipFuncSetAttribute((const void*)hyb_fwd, hipFuncAttributeMaxDynamicSharedMemorySize, LDS_BYTES) != hipSuccess) { fprintf(stderr, "kernel_launch: hipFuncSetAttribute failed\n"); grid = -1; return; }
        if (hipOccupancyMaxActiveBlocksPerMultiprocessor(&per_cu, (const void*)hyb_fwd, NWAVES * 64, LDS_BYTES) != hipSuccess || per_cu < 1)
            fprintf(stderr, "kernel_launch: note: occupancy query reports %d workgroups per CU\n", per_cu);
        (void)hipGetLastError();
        grid = cus;
    }
    if (grid < 0) return;
    if (hipMemsetAsync((char*)d_ws + WS_CTL, 0, CTL_ZERO_BYTES, stream) != hipSuccess) { fprintf(stderr, "kernel_launch: hipMemsetAsync failed\n"); return; }
    Args a{};
    for (int i = 0; i < 18; ++i) a.in[i] = (const float*)d_in[i];
    a.out = (float*)d_out; a.ws = (unsigned char*)d_ws;
    const int nl = (MK_N_LAUNCHES == 1) ? 1 : NPHASES;
    for (int li = 0; li < nl; ++li) {
        a.ph_lo = (nl == 1) ? 0 : li; a.ph_hi = (nl == 1) ? NPHASES : li + 1; a.li = li;
        hipLaunchKernelGGL(hyb_fwd, dim3(grid), dim3(NWAVES * 64), LDS_BYTES, stream, a);
        const hipError_t le = hipPeekAtLastError();
        if (le != hipSuccess) { fprintf(stderr, "kernel_launch: launch %d failed: %s\n", li, hipGetErrorName(le)); break; }
    }
}
```

```cpp
#include <hip/hip_runtime.h>
#include <cstdio>
#include <cstdint>
namespace pg8 {
#define PG8_LAS __attribute__((address_space(3)))
typedef unsigned short bf16_t;
typedef short bf16x8 __attribute__((ext_vector_type(8)));
typedef float f32x4 __attribute__((ext_vector_type(4)));
typedef unsigned u32x4 __attribute__((ext_vector_type(4)));
constexpr int BM = 256, BK = 64, HALF = 128, HTB = HALF * BK * 2  , STAGE_BYTES = 8 * HTB, NXCD = 8, WGM = 8;

__host__ __device__ __forceinline__ int lds_byte(int r, int c) { const int st = (r >> 4) * 2 + (c >> 5), rr = r & 15, cc = c & 31, ob = rr * 64 + cc * 2; return st * 1024 + (ob ^ (((ob >> 9) & 1) << 5)); }
__host__ __device__ __forceinline__ void stage_rc(int b, int& R, int& C) { const int st = b / 1024, sb = b % 1024, swz = sb ^ (((sb >> 9) & 1) << 5); R = (st >> 1) * 16 + swz / 64; C = (st & 1) * 32 + (swz % 64) / 2; }
__host__ __device__ __forceinline__ int perm32(int rho) { const int n = rho >> 4, i = rho & 15; return 8 * (i >> 2) + 4 * n + (i & 3); }

struct Unit { int pm, pn; };
struct Gemm { const bf16_t* A; const bf16_t* Bt; int M, N, K; };

struct StaticOrder {
    int nM, nN, nwg, G, c;
    __host__ __device__ void init(int M, int N, int G_, int c_) { nM = M / BM; nN = N / BM; nwg = nM * nN; G = G_; c = c_; }
    __host__ __device__ bool next(int i, Unit& u) const {
        const long L = (long)i * G + c; if (L >= nwg) return false;
        int wgid = (int)L; { const int q = nwg / NXCD, r = nwg % NXCD, xcd = wgid % NXCD, off = wgid / NXCD; wgid = (xcd < r ? xcd * (q + 1) : r * (q + 1) + (xcd - r) * q) + off; }
        const int nig = WGM * nN, gid = wgid / nig, fm = gid * WGM, gsz = (nM - fm) < WGM ? (nM - fm) : WGM;
        u.pm = fm + ((wgid % nig) % gsz); u.pn = (wgid % nig) / gsz; return true;
    }
    __device__ __forceinline__ void a_ready(const Unit&) const {}
    __device__ __forceinline__ void done(const Unit&) const {}
};

__device__ __forceinline__ unsigned cvt_pk_bf16(float lo, float hi) { unsigned r; asm volatile("v_cvt_pk_bf16_f32 %0, %1, %2" : "=v"(r) : "v"(lo), "v"(hi)); return r; }
typedef float f32x2 __attribute__((ext_vector_type(2)));
__device__ __forceinline__ f32x2 gelu_pk(f32x2 v) {
    const f32x2 av = __builtin_elementwise_abs(v), d = av * 0.2316418882f + 1.0f;
    f32x2 t; t.x = __builtin_amdgcn_rcpf(d.x); t.y = __builtin_amdgcn_rcpf(d.y);
    f32x2 q = t * 0.5307027145f + (-0.7265760135f); q = q * t + 0.7107068705f; q = q * t + (-0.142248368f); q = q * t + 0.127414796f; q = q * t;
    const f32x2 s = (v * v) * (-0.72134752044f);
    f32x2 e; e.x = __builtin_amdgcn_exp2f(s.x); e.y = __builtin_amdgcn_exp2f(s.y);
    const f32x2 m = v * (q * e), r = v - m;
    f32x2 o; o.x = v.x < 0.f ? m.x : r.x; o.y = v.y < 0.f ? m.y : r.y; return o;
}

template <int ACT  > struct EpiBf16 {
    static constexpr bool PERM = true, AFTER_DRAIN = false; static_assert(ACT == 0 || ACT == 1, "EpiBf16: ACT is 0 (none) or 1 (gelu_pk)");
    bf16_t* O; int ldc; const float* bias; int split_cols; size_t split_stride; float scale0;
    __device__ __forceinline__ void operator()(const f32x4 (&acc)[2][2][4][2], const Unit& u, int wr, int wc, int fr, int fq) const {
        const int row0 = u.pm * BM + wr * 64 + fr; int colt = u.pn * BM; bf16_t* base = O;
        float sc = 1.f; if (split_cols) { const int t = colt / split_cols; base += (size_t)t * split_stride; colt -= t * split_cols; if (t == 0) sc = scale0; }
        const int col0 = colt + wc * 32 + 8 * fq, bcol0 = u.pn * BM + wc * 32 + 8 * fq;
        f32x4 bv[2][2];
#pragma unroll
        for (int bj = 0; bj < 2; ++bj)
#pragma unroll
            for (int n = 0; n < 2; ++n) bv[bj][n] = bias ? *(const f32x4*)(bias + bcol0 + bj * HALF + 4 * n) : (f32x4){0.f, 0.f, 0.f, 0.f};
#pragma unroll
        for (int ai = 0; ai < 2; ++ai)
#pragma unroll
            for (int m = 0; m < 4; ++m) { bf16_t* rowp = base + (size_t)(row0 + ai * HALF + m * 16) * ldc + col0;
#pragma unroll
                for (int bj = 0; bj < 2; ++bj) { f32x4 v0 = acc[ai][bj][m][0] + bv[bj][0], v1 = acc[ai][bj][m][1] + bv[bj][1];
                    if (ACT == 1) { f32x2 a = gelu_pk((f32x2){v0[0], v0[1]}), b = gelu_pk((f32x2){v0[2], v0[3]}), c = gelu_pk((f32x2){v1[0], v1[1]}), d = gelu_pk((f32x2){v1[2], v1[3]});
                        v0 = (f32x4){a.x, a.y, b.x, b.y}; v1 = (f32x4){c.x, c.y, d.x, d.y}; }
                    v0 = v0 * sc; v1 = v1 * sc; u32x4 w; w.x = cvt_pk_bf16(v0[0], v0[1]); w.y = cvt_pk_bf16(v0[2], v0[3]); w.z = cvt_pk_bf16(v1[0], v1[1]); w.w = cvt_pk_bf16(v1[2], v1[3]);
                    *(u32x4*)(rowp + bj * HALF) = w; } }
    }
};
struct EpiProj {
    static constexpr bool PERM = true, AFTER_DRAIN = false;
    bf16_t* O; int ldc; int mode; float s_aq, s_gq;
    __device__ __forceinline__ void operator()(const f32x4 (&acc)[2][2][4][2], const Unit& u, int wr, int wc, int fr, int fq) const {
        const int row0 = u.pm * BM + wr * 64 + fr; const int col0 = u.pn * BM + wc * 32 + 8 * fq;
        float sc = 1.f; if (mode == 0) sc = (u.pn < 2) ? s_aq : (u.pn == 6 ? s_gq : 1.f);
#pragma unroll
        for (int ai = 0; ai < 2; ++ai)
#pragma unroll
            for (int m = 0; m < 4; ++m) { bf16_t* rowp = O + (size_t)(row0 + ai * HALF + m * 16) * ldc + col0;
#pragma unroll
                for (int bj = 0; bj < 2; ++bj) { f32x4 v0 = acc[ai][bj][m][0] * sc, v1 = acc[ai][bj][m][1] * sc;
                    u32x4 w; w.x = cvt_pk_bf16(v0[0], v0[1]); w.y = cvt_pk_bf16(v0[2], v0[3]); w.z = cvt_pk_bf16(v1[0], v1[1]); w.w = cvt_pk_bf16(v1[2], v1[3]);
                    *(u32x4*)(rowp + bj * HALF) = w; } }
    }
};
struct EpiF32 {
    static constexpr bool PERM = false, AFTER_DRAIN = false;
    float* O; int ldc;
    __device__ __forceinline__ void operator()(const f32x4 (&acc)[2][2][4][2], const Unit& u, int wr, int wc, int fr, int fq) const {
        const int col0 = u.pn * BM + wc * 32 + 4 * fq;
#pragma unroll
        for (int ai = 0; ai < 2; ++ai)
#pragma unroll
            for (int m = 0; m < 4; ++m) { const size_t off = (size_t)(u.pm * BM + ai * HALF + wr * 64 + m * 16 + fr) * ldc + col0;
#pragma unroll
                for (int bj = 0; bj < 2; ++bj)
#pragma unroll
                    for (int n = 0; n < 2; ++n) *(f32x4*)(O + off + bj * HALF + n * 16) = acc[ai][bj][m][n]; }
    }
};
template <class Epi, class Sched, bool ALIGN_EPI = false, bool SP2 = false>
__device__ __forceinline__ void gemm_phase(PG8_LAS unsigned char* lds, const Gemm g, const Sched& S, const Epi& E, int wave_in) {
    const int wid = wave_in, lane = (int)__builtin_amdgcn_mbcnt_hi(~0u, __builtin_amdgcn_mbcnt_lo(~0u, 0u)), tid = wid * 64 + lane, wr = wid >> 2, wc = wid & 3, fr = lane & 15, fq = lane >> 4;
    const int K = g.K, nt = K / BK;
    unsigned voffA[2], voffB[2];
#pragma unroll
    for (int i = 0; i < 2; ++i) { int R, C; stage_rc(tid * 16 + i * 8192, R, C); const int Rb = Epi::PERM ? ((R & ~31) + perm32(R & 31)) : R;
        voffA[i] = (unsigned)(R * K + C) * 2u; voffB[i] = (unsigned)(Rb * K + C) * 2u; }
    const size_t kstep = (size_t)(BK * 2);
    const size_t hstep = (size_t)HALF * K * 2;
    const size_t tstep = 2 * hstep;
    const unsigned ldsw = (unsigned)wid * 1024u;
    const int aoff = lds_byte(wr * 64 + fr, fq * 8), boff = lds_byte(wc * 32 + fr, fq * 8);
#define PG8_SA(b, h) (((b) * 2 + (h)) * HTB)
#define PG8_SB(b, h) ((4 + (b) * 2 + (h)) * HTB)
#define PG8_STAGE(bufoff, gbase, voff) do { _Pragma("unroll") for (int _i = 0; _i < 2; ++_i) \
        __builtin_amdgcn_global_load_lds((const unsigned*)((const char*)(gbase) + (voff)[_i]), (PG8_LAS unsigned*)(lds + (bufoff) + ldsw + _i * 8192), 16, 0, 0); } while (0)
#define PG8_LDA(dst, b, h) do { _Pragma("unroll") for (int m = 0; m < 4; ++m) _Pragma("unroll") for (int k = 0; k < 2; ++k) dst[m][k] = *(const PG8_LAS bf16x8*)(lds + PG8_SA(b, h) + aoff + m * 2048 + k * 1024); } while (0)
#define PG8_LDB(dst, b, h) do { _Pragma("unroll") for (int n = 0; n < 2; ++n) _Pragma("unroll") for (int k = 0; k < 2; ++k) dst[n][k] = *(const PG8_LAS bf16x8*)(lds + PG8_SB(b, h) + boff + n * 2048 + k * 1024); } while (0)
#define PG8_MMA(ai, bj, At, Bt) do { __builtin_amdgcn_s_setprio(1); _Pragma("unroll") for (int m = 0; m < 4; ++m) _Pragma("unroll") for (int n = 0; n < 2; ++n) _Pragma("unroll") for (int k = 0; k < 2; ++k) \
        acc[ai][bj][m][n] = __builtin_amdgcn_mfma_f32_16x16x32_bf16(Bt[n][k], At[m][k], acc[ai][bj][m][n], 0, 0, 0); __builtin_amdgcn_s_setprio(0); } while (0)
#define PG8_WAIT_V(n) asm volatile("s_waitcnt vmcnt(" #n ")" ::: "memory")
#define PG8_WAIT_L(n) asm volatile("s_waitcnt lgkmcnt(" #n ")" ::: "memory")
#define PG8_BAR __builtin_amdgcn_s_barrier()
#define PG8_SCHED __builtin_amdgcn_sched_barrier(0)
    Unit cur, nxt; int ui = 0;
    if (!S.next(0, cur)) return;
    f32x4 acc[2][2][4][2];
#pragma unroll
    for (int a = 0; a < 2; ++a)
#pragma unroll
        for (int b = 0; b < 2; ++b)
#pragma unroll
            for (int m = 0; m < 4; ++m)
#pragma unroll
                for (int n = 0; n < 2; ++n) acc[a][b][m][n] = (f32x4){0.f, 0.f, 0.f, 0.f};
    bf16x8 At[4][2], B0[2][2], B1[2][2];
    const char* cA = (const char*)g.A + (size_t)cur.pm * tstep; const char* cB = (const char*)g.Bt + (size_t)cur.pn * tstep;
    S.a_ready(cur);
    if constexpr (SP2) {
        PG8_STAGE(PG8_SB(0, 0), cB, voffB); PG8_STAGE(PG8_SB(0, 1), cB + hstep, voffB); PG8_STAGE(PG8_SA(0, 0), cA, voffA); PG8_STAGE(PG8_SA(0, 1), cA + hstep, voffA);
        if (wr == 1) PG8_BAR;
        PG8_WAIT_V(2); PG8_BAR;
        PG8_STAGE(PG8_SB(1, 0), cB + kstep, voffB); PG8_STAGE(PG8_SA(1, 0), cA + kstep, voffA); PG8_STAGE(PG8_SB(1, 1), cB + hstep + kstep, voffB);
        PG8_WAIT_V(6); PG8_BAR;
    } else {
        PG8_STAGE(PG8_SB(0, 0), cB, voffB); PG8_STAGE(PG8_SA(0, 0), cA, voffA); PG8_STAGE(PG8_SB(0, 1), cB + hstep, voffB); PG8_STAGE(PG8_SA(0, 1), cA + hstep, voffA);
        if (wr == 1) PG8_BAR;
        PG8_WAIT_V(4); PG8_BAR;
        PG8_STAGE(PG8_SB(1, 0), cB + kstep, voffB); PG8_STAGE(PG8_SA(1, 0), cA + kstep, voffA); PG8_STAGE(PG8_SB(1, 1), cB + hstep + kstep, voffB);
        PG8_WAIT_V(6); PG8_BAR;
    }
    for (;;) {
        const bool has_next = S.next(ui + 1, nxt);
        const char* nA = has_next ? (const char*)g.A + (size_t)nxt.pm * tstep : cA; const char* nB = has_next ? (const char*)g.Bt + (size_t)nxt.pn * tstep : cB;
        for (int t = 0; t < nt; t += 2) {
            const bool last = (t == nt - 2);
            const char* a1 = cA + (size_t)(t + 1) * kstep;
            const char* a2 = last ? nA : cA + (size_t)(t + 2) * kstep; const char* b2 = last ? nB : cB + (size_t)(t + 2) * kstep;
            const char* a3 = a2 + kstep; const char* b3 = b2 + kstep;
            if (last && has_next) S.a_ready(nxt);
            if constexpr (SP2) {
            PG8_LDB(B0, 0, 0); PG8_LDB(B1, 0, 1); PG8_SCHED; PG8_LDA(At, 0, 0); PG8_STAGE(PG8_SA(1, 1), a1 + hstep, voffA);
            PG8_WAIT_V(8); PG8_WAIT_L(0); PG8_BAR; PG8_MMA(0, 0, At, B0); PG8_MMA(0, 1, At, B1); PG8_BAR; PG8_SCHED;
            PG8_LDA(At, 0, 1); PG8_STAGE(PG8_SB(0, 0), b2, voffB); PG8_STAGE(PG8_SB(0, 1), b2 + hstep, voffB); PG8_STAGE(PG8_SA(0, 0), a2, voffA);
            PG8_WAIT_V(8); PG8_WAIT_L(0); PG8_BAR; PG8_MMA(1, 0, At, B0); PG8_MMA(1, 1, At, B1); PG8_BAR; PG8_SCHED;
            PG8_LDB(B0, 1, 0); PG8_LDB(B1, 1, 1); PG8_SCHED; PG8_LDA(At, 1, 0); PG8_STAGE(PG8_SA(0, 1), a2 + hstep, voffA);
            PG8_WAIT_V(8); PG8_WAIT_L(0); PG8_BAR; PG8_MMA(0, 0, At, B0); PG8_MMA(0, 1, At, B1); PG8_BAR; PG8_SCHED;
            PG8_LDA(At, 1, 1); PG8_STAGE(PG8_SB(1, 0), b3, voffB); PG8_STAGE(PG8_SB(1, 1), b3 + hstep, voffB); PG8_STAGE(PG8_SA(1, 0), a3, voffA);
            PG8_WAIT_V(8); PG8_WAIT_L(0); PG8_BAR; PG8_MMA(1, 0, At, B0); PG8_MMA(1, 1, At, B1); PG8_BAR; PG8_SCHED;
            } else {
            PG8_LDB(B0, 0, 0); PG8_SCHED; PG8_LDA(At, 0, 0); PG8_STAGE(PG8_SA(1, 1), a1 + hstep, voffA);
            PG8_WAIT_L(8); PG8_BAR; PG8_WAIT_L(0); PG8_MMA(0, 0, At, B0); PG8_BAR; PG8_SCHED;
            PG8_LDB(B1, 0, 1); PG8_STAGE(PG8_SB(0, 0), b2, voffB);
            PG8_BAR; PG8_WAIT_L(0); PG8_MMA(0, 1, At, B1); PG8_BAR;
            PG8_LDA(At, 0, 1); PG8_STAGE(PG8_SA(0, 0), a2, voffA);
            PG8_BAR; PG8_WAIT_L(0); PG8_MMA(1, 0, At, B0); PG8_BAR; PG8_SCHED;
            PG8_STAGE(PG8_SB(0, 1), b2 + hstep, voffB);
            PG8_WAIT_V(6); PG8_BAR; PG8_MMA(1, 1, At, B1); PG8_BAR;
            PG8_LDB(B0, 1, 0); PG8_SCHED; PG8_LDA(At, 1, 0); PG8_STAGE(PG8_SA(0, 1), a2 + hstep, voffA);
            PG8_WAIT_L(8); PG8_BAR; PG8_WAIT_L(0); PG8_MMA(0, 0, At, B0); PG8_BAR; PG8_SCHED;
            PG8_LDB(B1, 1, 1); PG8_STAGE(PG8_SB(1, 0), b3, voffB);
            PG8_BAR; PG8_WAIT_L(0); PG8_MMA(0, 1, At, B1); PG8_BAR;
            PG8_LDA(At, 1, 1); PG8_STAGE(PG8_SA(1, 0), a3, voffA);
            PG8_BAR; PG8_WAIT_L(0); PG8_MMA(1, 0, At, B0); PG8_BAR; PG8_SCHED;
            PG8_STAGE(PG8_SB(1, 1), b3 + hstep, voffB);
            PG8_WAIT_V(6); PG8_BAR; PG8_MMA(1, 1, At, B1); PG8_BAR;
            }
        }
        if constexpr (ALIGN_EPI) { if (wr == 0) PG8_BAR; }
        if constexpr (!Epi::AFTER_DRAIN) { E(acc, cur, wr, wc, fr, fq); S.done(cur); }
        if (!has_next) break;
#pragma unroll
        for (int a = 0; a < 2; ++a)
#pragma unroll
            for (int b = 0; b < 2; ++b)
#pragma unroll
                for (int m = 0; m < 4; ++m)
#pragma unroll
                    for (int n = 0; n < 2; ++n) acc[a][b][m][n] = (f32x4){0.f, 0.f, 0.f, 0.f};
        cur = nxt; cA = nA; cB = nB; ++ui;
        if constexpr (ALIGN_EPI) { if (wr == 1) PG8_BAR; }
    }
    PG8_WAIT_V(0);
    if constexpr (!ALIGN_EPI) { if (wr == 0) PG8_BAR; }
    PG8_BAR;
    if constexpr (Epi::AFTER_DRAIN) { E.fused(acc, cur, wr, wc, fr, fq, lds, wid, lane); S.done(cur); }
#undef PG8_SA
#undef PG8_SB
#undef PG8_STAGE
#undef PG8_LDA
#undef PG8_LDB
#undef PG8_MMA
#undef PG8_WAIT_V
#undef PG8_WAIT_L
#undef PG8_BAR
#undef PG8_SCHED
}
}
#ifndef PG8_SP2
#define PG8_SP2 true
#endif
#ifndef PG8_ALIGN
#define PG8_ALIGN true
#endif

constexpr int NWAVES = 8;
#ifndef MK_N_LAUNCHES
#define MK_N_LAUNCHES 1
#endif
constexpr int NPHASES = 13;
#ifndef PEER_FP8
#define PEER_FP8 1
#endif

constexpr int BATCH = 2, SEQ = 8192, DM = 1024, M = BATCH * SEQ;
constexpr int DIN = 3088, NPROJ = 3072;
constexpr int C_AQ = 0, C_AK = 512, C_AV = 1024, C_GQ = 1536, C_GK = 1792, C_GV = 2048, C_GR = 2560, C_GLR = 3072;
constexpr int NH = 8;
constexpr int GH = 4, GDK = 64, GDV = 128, NCHUNK = SEQ / 64;
constexpr int PQD = 2048, NEXP = 16384;
constexpr float EPS = 1e-6f;
constexpr float LOG2E = 1.4426950408889634f;
constexpr float C2 = 0.125f * LOG2E;

constexpr size_t MiB = 1u << 20;
constexpr size_t WS_CTL = 0, CTL_ZERO_BYTES = 1 * MiB;
constexpr size_t WS_WIN = 2 * MiB, WS_WOUT = 8 * MiB, WS_WPQ = 10 * MiB, WS_SUBK = 14 * MiB, WS_DEC = 15 * MiB;
constexpr size_t WS_U16 = 16 * MiB, WS_V16 = 48 * MiB;
constexpr size_t WS_XN = 80 * MiB;
constexpr size_t WS_PROJ = 112 * MiB;
constexpr size_t WS_EIDX = 176 * MiB, WS_GATE = 184 * MiB;
constexpr size_t WS_PART = 192 * MiB;
constexpr size_t WS_Y2 = 112 * MiB;
constexpr size_t WS_LOGA = 208 * MiB;
constexpr size_t WS_UT = 224 * MiB, WS_END = 256 * MiB;
constexpr int CW_TMO = 0, CW_BAR = 4096, CW_MOD = 65536;
constexpr int MOD_SH1 = 0, MOD_SC1 = 1024, MOD_GA1 = 2048, MOD_SH2 = 3072, MOD_SC2 = 4096, MOD_GA2 = 5120, MOD_LD = 6144;

constexpr int RING_OFF = 0, RING_BYTES = 131072;
constexpr int LDSCTL_OFF = RING_BYTES, MISC_OFF = LDSCTL_OFF + 320;
constexpr int LDS_BYTES = 147456;

#define GAS __attribute__((address_space(1)))
#define LAS __attribute__((address_space(3)))
typedef unsigned short bf16;
typedef unsigned v4u __attribute__((ext_vector_type(4)));
typedef unsigned v2u __attribute__((ext_vector_type(2)));
typedef float f32x4 __attribute__((ext_vector_type(4)));
typedef float f32x2 __attribute__((ext_vector_type(2)));
typedef short bf16x8 __attribute__((ext_vector_type(8)));
typedef short s16x4 __attribute__((ext_vector_type(4)));
typedef __bf16 bf16x2_t __attribute__((ext_vector_type(2)));
typedef GAS unsigned gu32;
#define RLX_AGENT __ATOMIC_RELAXED, __HIP_MEMORY_SCOPE_AGENT
#define LDS_WAIT() asm volatile("s_waitcnt lgkmcnt(0)" ::: "memory")
#define VM_WAIT() asm volatile("s_waitcnt vmcnt(0)" ::: "memory")
__device__ __forceinline__ unsigned f2bf(float f) { unsigned u = __builtin_bit_cast(unsigned, f); return (u + 0x7fffu + ((u >> 16) & 1u)) >> 16; }
__device__ __forceinline__ unsigned pk2(float lo, float hi) { f32x2 v = {lo, hi}; bf16x2_t b = __builtin_convertvector(v, bf16x2_t); return __builtin_bit_cast(unsigned, b); }
__device__ __forceinline__ float bflo(unsigned w) { return __builtin_bit_cast(float, w << 16); }
__device__ __forceinline__ float bfhi(unsigned w) { return __builtin_bit_cast(float, w & 0xffff0000u); }
__device__ __forceinline__ float dot2bf(unsigned a, unsigned b, float acc) { return __builtin_amdgcn_fdot2_f32_bf16(__builtin_bit_cast(bf16x2_t, a), __builtin_bit_cast(bf16x2_t, b), acc, false); }
__device__ __forceinline__ f32x4 mfma16(bf16x8 a, bf16x8 b, f32x4 c) { return __builtin_amdgcn_mfma_f32_16x16x32_bf16(a, b, c, 0, 0, 0); }
typedef short v4i16_t __attribute__((ext_vector_type(4)));
__device__ __forceinline__ s16x4 tr16(const LAS unsigned char* p) { return __builtin_bit_cast(s16x4, __builtin_amdgcn_ds_read_tr16_b64_v4i16((LAS v4i16_t*)p)); }
__device__ __forceinline__ bf16x8 cat8(s16x4 lo, s16x4 hi) { return (bf16x8){lo[0], lo[1], lo[2], lo[3], hi[0], hi[1], hi[2], hi[3]}; }
__device__ __forceinline__ bf16x8 pack8(f32x4 a, f32x4 b) { v4u w; w.x = pk2(a[0], a[1]); w.y = pk2(a[2], a[3]); w.z = pk2(b[0], b[1]); w.w = pk2(b[2], b[3]); return __builtin_bit_cast(bf16x8, w); }
__device__ __forceinline__ float wave_sum(float v) {
#pragma unroll
    for (int o = 1; o < 64; o <<= 1) v += __shfl_xor(v, o);
    return v;
}

#define XB_TMO      128
#define XB_XCNT(j)  (256  + 64 * (j))
#define XB_XSUB(j)  (1280 + 64 * (j))
#define XB_XGEN(j)  (2304 + 64 * (j))
#define XB_TOP      3328
#define XB_TOPGEN   3392
#define XCD_BAR_WORDS 3456
#define XB_SPIN_CAP (1u << 18)
__device__ __forceinline__ unsigned xb_ld(unsigned* p)              { return __hip_atomic_load(p, __ATOMIC_RELAXED, __HIP_MEMORY_SCOPE_AGENT); }
__device__ __forceinline__ unsigned xb_add(unsigned* p, unsigned v) { return __hip_atomic_fetch_add(p, v, __ATOMIC_RELAXED, __HIP_MEMORY_SCOPE_AGENT); }
__device__ __forceinline__ unsigned xb_xcc_id() { return (unsigned)__builtin_amdgcn_s_getreg((3 << 11) | 20) & 0xFu; }
#define XB_SPIN(cond, bar) do { unsigned _sp = 0; while (cond) { __builtin_amdgcn_s_sleep(1); \
    if ((++_sp & 255u) == 0u) { if (xb_ld(&(bar)[XB_TMO])) break; if (_sp > XB_SPIN_CAP) { atomicAdd(&(bar)[XB_TMO], 1u); break; } } } } while (0)
struct XcdBarrier { unsigned* bar; unsigned x; volatile LAS unsigned* st; };
__device__ __forceinline__ int mk_lane() { return (int)__builtin_amdgcn_mbcnt_hi(~0u, __builtin_amdgcn_mbcnt_lo(~0u, 0u)); }
__device__ __forceinline__ XcdBarrier xcd_barrier_post(unsigned* bar, volatile LAS unsigned* st, int wave) {
    XcdBarrier b; b.bar = bar; b.x = xb_xcc_id(); b.st = st;
    if (wave == 0 && mk_lane() == 0) (void)xb_add(&bar[XB_XCNT(b.x)], 1u);
    return b;
}
__device__ __forceinline__ void xcd_barrier_complete(unsigned* bar, unsigned x, unsigned& nloc, unsigned& nx) {
    const unsigned G = gridDim.x * gridDim.y * gridDim.z;
    unsigned sum, cnt, mine, sp = 0u;
    for (;;) {
        sum = 0u; cnt = 0u; mine = 0u;
#pragma unroll
        for (unsigned j = 0; j < 16; ++j) { const unsigned c = xb_ld(&bar[XB_XCNT(j)]); sum += c; cnt += (c > 0u) ? 1u : 0u; mine = (j == x) ? c : mine; }
        if (sum == G) break;
        __builtin_amdgcn_s_sleep(1);
        if ((++sp & 255u) == 0u) { if (xb_ld(&bar[XB_TMO])) break; if (sp > XB_SPIN_CAP) { atomicAdd(&bar[XB_TMO], 1u); break; } }
    }
    nloc = mine > 0u ? mine : 1u; nx = cnt > 0u ? cnt : 1u;
}
__device__ __forceinline__ void xcd_barrier(const XcdBarrier& b, int wave) {
    asm volatile("s_waitcnt vmcnt(0)" ::: "memory");
    __syncthreads();
    if (wave == 0 && mk_lane() == 0) {
        unsigned* bar = b.bar;
        __builtin_amdgcn_s_waitcnt(0);
        unsigned nloc = b.st[0], nx = b.st[1];
        if (nloc == 0u) { xcd_barrier_complete(bar, b.x, nloc, nx); b.st[0] = nloc; b.st[1] = nx; }
        const unsigned old = xb_add(&bar[XB_XSUB(b.x)], 1u);
        const unsigned gen = old / nloc;
        if (old + 1u == (gen + 1u) * nloc) {
            __builtin_amdgcn_fence(__ATOMIC_RELEASE, "agent");
            asm volatile("s_waitcnt vmcnt(0)" ::: "memory");
            const unsigned og = xb_add(&bar[XB_TOP], 1u);
            const unsigned tg = og / nx;
            if (og + 1u == (tg + 1u) * nx) xb_add(&bar[XB_TOPGEN], 1u);
            else XB_SPIN(xb_ld(&bar[XB_TOPGEN]) == tg, bar);
            __builtin_amdgcn_fence(__ATOMIC_ACQUIRE, "agent");
            xb_add(&bar[XB_XGEN(b.x)], 1u);
            asm volatile("s_waitcnt vmcnt(0)" ::: "memory");
        } else {
            XB_SPIN(xb_ld(&bar[XB_XGEN(b.x)]) == gen, bar);
            __builtin_amdgcn_fence(__ATOMIC_ACQUIRE, "agent");
            asm volatile("s_waitcnt vmcnt(0)" ::: "memory");
        }
    }
    __syncthreads();
}

struct Args { const float* in[18]; float* out; unsigned char* ws; int ph_lo, ph_hi, li, pad; };
#define FIN(i) (F.A->in[i])
struct Frame {
    LAS unsigned char* lds;
    volatile LAS unsigned* MISC;
    gu32* ctl;
    int tid, lane, wave;
    int vcu, G;
    const __attribute__((address_space(4))) struct Args* A;
};
#define WSP(T, off) ((T*)(F.A->ws + (off)))

__device__ __forceinline__ bool launder(Frame& F) {
    unsigned long long p = (unsigned long long)F.A; unsigned lo = (unsigned)p, hi = (unsigned)(p >> 32);
    asm volatile("" : "+v"(lo), "+v"(hi));
    lo = (unsigned)__builtin_amdgcn_readfirstlane((int)lo); hi = (unsigned)__builtin_amdgcn_readfirstlane((int)hi);
    F.A = (const __attribute__((address_space(4))) struct Args*)(((unsigned long long)hi << 32) | lo);
    F.lane = mk_lane(); F.tid = F.wave * 64 + F.lane;
    return true; }
__device__ __forceinline__ void p0_transpose_item(const float* W, int ldw, int K, int nblk, bf16* WT, LAS float* scr, int item, int lane) {
    const int kb = item / nblk, nb = item % nblk, k0 = 64 * kb, n0 = 32 * nb;
#pragma unroll 8
    for (int i = 0; i < 32; ++i) { const int kk = 2 * i + (lane >> 5); scr[kk * 33 + (lane & 31)] = W[(size_t)(k0 + kk) * ldw + n0 + (lane & 31)]; }
    LDS_WAIT(); asm volatile("" ::: "memory");
    const int c = lane & 7;
#pragma unroll
    for (int j = 0; j < 4; ++j) { const int n = (lane >> 3) + 8 * j; const LAS float* s = scr + (8 * c) * 33 + n;
        v4u o; o.x = pk2(s[0 * 33], s[1 * 33]); o.y = pk2(s[2 * 33], s[3 * 33]); o.z = pk2(s[4 * 33], s[5 * 33]); o.w = pk2(s[6 * 33], s[7 * 33]);
        *(GAS v4u*)(WT + (size_t)(n0 + n) * K + k0 + 8 * c) = o; }
    LDS_WAIT(); asm volatile("" ::: "memory");
}
__device__ __forceinline__ void cvt_stream(const float* src, bf16* dst, size_t nvec8, int gw, int NGW, int lane) {
    for (size_t i = (size_t)gw * 64 + lane; i < nvec8; i += (size_t)NGW * 64) {
        const f32x4 a = *(const GAS f32x4*)(src + i * 8), b = *(const GAS f32x4*)(src + i * 8 + 4);
        v4u o; o.x = pk2(a[0], a[1]); o.y = pk2(a[2], a[3]); o.z = pk2(b[0], b[1]); o.w = pk2(b[2], b[3]);
        *(GAS v4u*)(dst + i * 8) = o; }
}
__device__ __forceinline__ void cvt_sliced(const float* src, bf16* dst, int gw, int NGW, int lane) {
    const size_t nvec8 = (size_t)NEXP * DM / 8;
    for (size_t i = (size_t)gw * 64 + lane; i < nvec8; i += (size_t)NGW * 64) {
        const f32x4 a = *(const GAS f32x4*)(src + i * 8), b = *(const GAS f32x4*)(src + i * 8 + 4);
        v4u o; o.x = pk2(a[0], a[1]); o.y = pk2(a[2], a[3]); o.z = pk2(b[0], b[1]); o.w = pk2(b[2], b[3]);
        const size_t e = i >> 7; const int cv = (int)(i & 127), sl = cv >> 4, wi = (cv & 15) * 8;
        *(GAS v4u*)(dst + ((size_t)sl * NEXP + e) * 128 + wi) = o; }
}
__device__ __forceinline__ void cvt_sliced8(const float* src, unsigned char* dst, int gw, int NGW, int lane) {
    const size_t nvec16 = (size_t)NEXP * DM / 16;
    for (size_t i = (size_t)gw * 64 + lane; i < nvec16; i += (size_t)NGW * 64) {
        v4u o;
#pragma unroll
        for (int q = 0; q < 4; ++q) { const f32x4 a = *(const GAS f32x4*)(src + i * 16 + 4 * q) * 512.f;
            int w = 0; w = __builtin_amdgcn_cvt_pk_fp8_f32(a[0], a[1], w, false); w = __builtin_amdgcn_cvt_pk_fp8_f32(a[2], a[3], w, true); o[q] = (unsigned)w; }
        const size_t e = i >> 6; const int cv = (int)(i & 63), sl = cv >> 3, wi = (cv & 7) * 16;
        *(GAS v4u*)(dst + ((size_t)sl * NEXP + e) * 128 + wi) = o; }
}
__device__ __forceinline__ void p0_prologue(Frame& F) {
    LAS float* scr = (LAS float*)(F.lds + RING_OFF + F.wave * 16384);
    const int gw = F.vcu * NWAVES + F.wave, NGW = F.G * NWAVES, lane = F.lane;
    float* MOD = (float*)(F.ctl + CW_MOD);
    for (int nb = F.vcu; nb < 96; nb += F.G) {
        const int n = nb * 64 + lane;
        float a0 = 0.f, a1 = 0.f;
#pragma unroll 8
        for (int kk = 0; kk < 128; ++kk) { const int k = F.wave * 128 + kk; const float w = FIN(2)[(size_t)k * 6144 + n];
            const float c0 = FIN(1)[k], c1 = FIN(1)[1024 + k];
            a0 += (c0 / (1.f + __expf(-c0))) * w; a1 += (c1 / (1.f + __expf(-c1))) * w; }
        LAS float* red = (LAS float*)(F.lds + RING_OFF + F.wave * 16384 + 12288);
        red[lane] = a0; red[64 + lane] = a1;
        __syncthreads();
        if (F.wave == 0) {
            float s0 = FIN(3)[n], s1 = s0;
#pragma unroll
            for (int w = 0; w < 8; ++w) { const LAS float* rw = (const LAS float*)(F.lds + RING_OFF + w * 16384 + 12288); s0 += rw[lane]; s1 += rw[64 + lane]; }
            MOD[n] = s0; MOD[MOD_LD + n] = s1;
        }
        __syncthreads();
    }
    constexpr int I_IN = 16 * 96, I_OUT = 16 * 32, I_PQ = 16 * 64;
    for (int it = gw; it < I_IN + I_OUT + I_PQ; it += NGW) {
        int r = it;
        if (r < I_IN) { p0_transpose_item(FIN(6), DIN, DM, 96, WSP(bf16, WS_WIN), scr, r, lane); continue; } r -= I_IN;
        if (r < I_OUT) { p0_transpose_item(FIN(11), DM, DM, 32, WSP(bf16, WS_WOUT), scr, r, lane); continue; } r -= I_OUT;
        p0_transpose_item(FIN(14), PQD, DM, 64, WSP(bf16, WS_WPQ), scr, r, lane);
    }
    cvt_stream(FIN(15), WSP(bf16, WS_SUBK), (size_t)8 * 2 * 128 * 128 / 8, gw, NGW, lane);
#if PEER_FP8
    cvt_sliced8(FIN(16), WSP(unsigned char, WS_U16), gw, NGW, lane);
    cvt_sliced8(FIN(17), WSP(unsigned char, WS_V16), gw, NGW, lane);
#else
    cvt_sliced(FIN(16), WSP(bf16, WS_U16), gw, NGW, lane);
    cvt_sliced(FIN(17), WSP(bf16, WS_V16), gw, NGW, lane);
#endif
}

constexpr int P1_WGL = 0, P1_WG2 = 81920, P1_BG = 98304;
__device__ __forceinline__ float log_sigmoid(float z) { return fminf(z, 0.f) - log1pf(__expf(-fabsf(z))); }
__device__ __forceinline__ void p1_modulate(Frame& F) {
    LAS float* WGL = (LAS float*)(F.lds + P1_WGL); LAS float* WG2 = (LAS float*)(F.lds + P1_WG2); LAS float* BG = (LAS float*)(F.lds + P1_BG);
    for (int idx = F.tid; idx < 1024 * 16; idx += NWAVES * 64) { const int k = idx >> 4, c = idx & 15; const int j = k >> 8, l = (k >> 2) & 63, e = k & 3;
        WGL[((j * 4 + e) * 64 + l) * 20 + c] = FIN(6)[(size_t)k * DIN + C_GLR + c]; }
    for (int idx = F.tid; idx < 16 * 256; idx += NWAVES * 64) WG2[idx] = FIN(7)[idx];
    for (int idx = F.tid; idx < 256; idx += NWAVES * 64) BG[idx] = FIN(8)[idx];
    __syncthreads();
    const int gw = F.vcu * NWAVES + F.wave, NGW = F.G * NWAVES, lane = F.lane;
    const float* MOD = (const float*)(F.ctl + CW_MOD);
    bf16* XN = WSP(bf16, WS_XN); float* LOGA = WSP(float, WS_LOGA);
    for (int m = gw; m < M; m += NGW) {
        const int b = m >> 13;
        const GAS f32x4* xr = (const GAS f32x4*)(FIN(0) + (size_t)m * DM) + lane;
        f32x4 v[4]; float s = 0.f;
#pragma unroll
        for (int j = 0; j < 4; ++j) { v[j] = xr[64 * j]; s += (v[j].x * v[j].x + v[j].y * v[j].y) + (v[j].z * v[j].z + v[j].w * v[j].w); }
        const float rstd = 1.f / sqrtf(wave_sum(s) * (1.f / DM) + EPS);
        float part[16];
#pragma unroll
        for (int c = 0; c < 16; ++c) part[c] = 0.f;
        GAS v2u* o8 = (GAS v2u*)(XN + (size_t)m * DM) + lane;
#pragma unroll
        for (int j = 0; j < 4; ++j) {
            const f32x4 g = *(const GAS f32x4*)(FIN(4) + 256 * j + 4 * lane);
            const f32x4 sc = *(const GAS f32x4*)(MOD + b * MOD_LD + MOD_SC1 + 256 * j + 4 * lane), sh = *(const GAS f32x4*)(MOD + b * MOD_LD + MOD_SH1 + 256 * j + 4 * lane);
            f32x4 h = v[j] * rstd * g * (sc + 1.f) + sh;
            v2u w; w.x = pk2(h.x, h.y); w.y = pk2(h.z, h.w); o8[64 * j] = w;
#pragma unroll
            for (int e = 0; e < 4; ++e) { const LAS float* wp = WGL + ((j * 4 + e) * 64 + lane) * 20; const float hv = h[e];
#pragma unroll
                for (int c4 = 0; c4 < 4; ++c4) { const f32x4 w4 = *(const LAS f32x4*)(wp + 4 * c4);
                    part[4 * c4 + 0] += hv * w4.x; part[4 * c4 + 1] += hv * w4.y; part[4 * c4 + 2] += hv * w4.z; part[4 * c4 + 3] += hv * w4.w; }
                asm volatile("" ::: "memory"); }
        }
#pragma unroll
        for (int c = 0; c < 16; ++c) part[c] = wave_sum(part[c]);
#pragma unroll
        for (int i = 0; i < 4; ++i) { const int n = lane + 64 * i; float z = BG[n];
#pragma unroll
            for (int c = 0; c < 16; ++c) z += part[c] * WG2[c * 256 + n];
            LOGA[(size_t)m * 256 + n] = log_sigmoid(z) * (1.f / 16.f); }
    }
}
constexpr int GL_HALF = 45056, GL_BC = 0, GL_K = 16384, GL_V = 25600, GL_TOT = 43008, GL_Q = 44032;
constexpr int GL_HALF5 = 53248;
constexpr int KP = 72, VP = 136;
__device__ __forceinline__ void gla_bcum(const float* LOGA, int b, int h, int c, LAS float* bc, LAS float* tot, int tl) {
    const int d = tl & 63, qt = tl >> 6;
    float loc[16]; float run = 0.f;
    const float* src = LOGA + ((size_t)(b * SEQ + c * 64 + qt * 16)) * 256 + h * 64 + d;
#pragma unroll
    for (int i = 0; i < 16; ++i) { run += src[(size_t)i * 256]; loc[i] = run; }
    tot[qt * 64 + d] = run;
    __syncthreads();
    float off = 0.f;
#pragma unroll
    for (int q = 0; q < 3; ++q) if (q < qt) off += tot[q * 64 + d];
#pragma unroll
    for (int i = 0; i < 16; ++i) bc[(qt * 16 + i) * 64 + d] = loc[i] + off;
    __syncthreads();
}
__device__ __forceinline__ void gla_prep_item(Frame& F, int item, LAS unsigned char* L, int tl, int wl, int lane) {
    const int bh = item >> 7, c = item & 127, b = bh >> 2, h = bh & 3;
    LAS float* bc = (LAS float*)(L + GL_BC); LAS float* tot = (LAS float*)(L + GL_TOT);
    LAS bf16* kh = (LAS bf16*)(L + GL_K); LAS bf16* vv = (LAS bf16*)(L + GL_V);
    const bf16* PROJ = WSP(bf16, WS_PROJ);
    gla_bcum(WSP(float, WS_LOGA), b, h, c, bc, tot, tl);
    const size_t row0 = (size_t)b * SEQ + c * 64;
#pragma unroll
    for (int rep = 0; rep < 2; ++rep) { const int p = tl + 256 * rep, i = p >> 3, o = p & 7;
        const v4u kw = *(const GAS v4u*)(PROJ + (row0 + i) * NPROJ + C_GK + h * 64 + 8 * o);
        float f[8];
#pragma unroll
        for (int e = 0; e < 4; ++e) { f[2 * e] = bflo(kw[e]); f[2 * e + 1] = bfhi(kw[e]); }
#pragma unroll
        for (int e = 0; e < 8; ++e) f[e] *= __expf(bc[63 * 64 + 8 * o + e] - bc[i * 64 + 8 * o + e]);
        v4u ow; ow.x = pk2(f[0], f[1]); ow.y = pk2(f[2], f[3]); ow.z = pk2(f[4], f[5]); ow.w = pk2(f[6], f[7]);
        *(LAS v4u*)(kh + i * KP + 8 * o) = ow; }
#pragma unroll
    for (int rep = 0; rep < 4; ++rep) { const int p = tl + 256 * rep, i = p >> 4, o = p & 15;
        *(LAS v4u*)(vv + i * VP + 8 * o) = *(const GAS v4u*)(PROJ + (row0 + i) * NPROJ + C_GV + h * 128 + 8 * o); }
    __syncthreads();
    const int i16 = lane & 15, g = lane >> 4;
    f32x4 acc[2][4];
#pragma unroll
    for (int a = 0; a < 2; ++a)
#pragma unroll
        for (int n = 0; n < 4; ++n) acc[a][n] = (f32x4){0.f, 0.f, 0.f, 0.f};
#pragma unroll
    for (int ks = 0; ks < 2; ++ks) {
        bf16x8 A[2], B[4];
        const int krow = 32 * ks + 8 * g + (i16 >> 2);
#pragma unroll
        for (int a = 0; a < 2; ++a) { const LAS unsigned char* p = (const LAS unsigned char*)(vv + krow * VP + 16 * (2 * wl + a) + 4 * (i16 & 3)); A[a] = cat8(tr16(p), tr16(p + 4 * VP * 2)); }
#pragma unroll
        for (int n = 0; n < 4; ++n) { const LAS unsigned char* p = (const LAS unsigned char*)(kh + krow * KP + 16 * n + 4 * (i16 & 3)); B[n] = cat8(tr16(p), tr16(p + 4 * KP * 2)); }
#pragma unroll
        for (int a = 0; a < 2; ++a)
#pragma unroll
            for (int n = 0; n < 4; ++n) acc[a][n] = mfma16(A[a], B[n], acc[a][n]);
    }
    float* UT = WSP(float, WS_UT) + (size_t)(bh * 128 + c) * 8192;
#pragma unroll
    for (int a = 0; a < 2; ++a)
#pragma unroll
        for (int n = 0; n < 4; ++n)
#pragma unroll
            for (int r = 0; r < 4; ++r) UT[(16 * (2 * wl + a) + 4 * g + r) * 64 + 16 * n + i16] = acc[a][n][r];
    if (tl < 64) WSP(float, WS_DEC)[(size_t)(bh * 128 + c) * 64 + tl] = __expf(bc[63 * 64 + tl]);
    __syncthreads();
}
__device__ __forceinline__ void gla_scan(Frame& F) {
    if (F.tid >= 256) return;
    float* UT = WSP(float, WS_UT); const float* DEC = WSP(float, WS_DEC);
    for (int blk = F.vcu; blk < 256; blk += F.G) {
        const int bh = blk >> 5, e = (blk & 31) * 4 + (F.tid >> 6), d = F.tid & 63;
        float* p = UT + (size_t)bh * 128 * 8192 + e * 64 + d; const float* dc = DEC + (size_t)bh * 128 * 64 + d;
        float S = 0.f;
        for (int c0 = 0; c0 < 128; c0 += 8) {
            float u[8], a[8];
#pragma unroll
            for (int j = 0; j < 8; ++j) { u[j] = p[(size_t)(c0 + j) * 8192]; a[j] = dc[(c0 + j) * 64]; }
#pragma unroll
            for (int j = 0; j < 8; ++j) { p[(size_t)(c0 + j) * 8192] = S; S = a[j] * S + u[j]; }
        }
    }
}
__device__ __forceinline__ void gla_out_item(Frame& F, int item, LAS unsigned char* L, int tl, int wl, int lane) {
    const int bh = item >> 7, c = item & 127, b = bh >> 2, h = bh & 3;
    LAS float* bc = (LAS float*)(L + GL_BC); LAS float* tot = (LAS float*)(L + GL_TOT);
    LAS bf16* kt = (LAS bf16*)(L + GL_K); LAS bf16* vv = (LAS bf16*)(L + GL_V); LAS bf16* qs = (LAS bf16*)(L + GL_Q);
    const bf16* PROJ = WSP(bf16, WS_PROJ);
    gla_bcum(WSP(float, WS_LOGA), b, h, c, bc, tot, tl);
    const size_t row0 = (size_t)b * SEQ + c * 64;
#pragma unroll
    for (int rep = 0; rep < 2; ++rep) { const int p = tl + 256 * rep, i = p >> 3, o = p & 7;
        const v4u kw = *(const GAS v4u*)(PROJ + (row0 + i) * NPROJ + C_GK + h * 64 + 8 * o);
        const v4u qw = *(const GAS v4u*)(PROJ + (row0 + i) * NPROJ + C_GQ + h * 64 + 8 * o);
        float fk[8], fq[8];
#pragma unroll
        for (int e = 0; e < 4; ++e) { fk[2 * e] = bflo(kw[e]); fk[2 * e + 1] = bfhi(kw[e]); fq[2 * e] = bflo(qw[e]); fq[2 * e + 1] = bfhi(qw[e]); }
#pragma unroll
        for (int e = 0; e < 8; ++e) { const float bb = bc[i * 64 + 8 * o + e]; fk[e] *= __expf(-bb); fq[e] *= __expf(bb); }
        v4u ow; ow.x = pk2(fk[0], fk[1]); ow.y = pk2(fk[2], fk[3]); ow.z = pk2(fk[4], fk[5]); ow.w = pk2(fk[6], fk[7]);
        *(LAS v4u*)(kt + i * KP + 8 * o) = ow;
        ow.x = pk2(fq[0], fq[1]); ow.y = pk2(fq[2], fq[3]); ow.z = pk2(fq[4], fq[5]); ow.w = pk2(fq[6], fq[7]);
        *(LAS v4u*)(qs + i * KP + 8 * o) = ow; }
#pragma unroll
    for (int rep = 0; rep < 4; ++rep) { const int p = tl + 256 * rep, i = p >> 4, o = p & 15;
        *(LAS v4u*)(vv + i * VP + 8 * o) = *(const GAS v4u*)(PROJ + (row0 + i) * NPROJ + C_GV + h * 128 + 8 * o); }
    __syncthreads();
    const int i16 = lane & 15, g = lane >> 4;
    const int itok = 16 * wl + i16;
    bf16x8 Bq[2];
#pragma unroll
    for (int ks = 0; ks < 2; ++ks) Bq[ks] = *(const LAS bf16x8*)(qs + itok * KP + 32 * ks + 8 * g);
    bf16x8 Pf[2];
#pragma unroll
    for (int jp = 0; jp < 2; ++jp) {
        const int ja = 32 * jp + 8 * (i16 >> 2) + (i16 & 3), jb = ja + 4;
        f32x4 sa = {0.f, 0.f, 0.f, 0.f}, sb = {0.f, 0.f, 0.f, 0.f};
#pragma unroll
        for (int ks = 0; ks < 2; ++ks) {
            const bf16x8 Aa = *(const LAS bf16x8*)(kt + ja * KP + 32 * ks + 8 * g), Ab = *(const LAS bf16x8*)(kt + jb * KP + 32 * ks + 8 * g);
            sa = mfma16(Aa, Bq[ks], sa); sb = mfma16(Ab, Bq[ks], sb); }
#pragma unroll
        for (int r = 0; r < 4; ++r) { const int j = 32 * jp + 8 * g + r; sa[r] = (j <= itok) ? sa[r] : 0.f; sb[r] = (j + 4 <= itok) ? sb[r] : 0.f; }
        Pf[jp] = pack8(sa, sb);
    }
    f32x4 acc[8];
    const float* ST = WSP(float, WS_UT) + (size_t)(bh * 128 + c) * 8192;
#pragma unroll
    for (int mt = 0; mt < 8; ++mt) {
        f32x4 a = {0.f, 0.f, 0.f, 0.f};
#pragma unroll
        for (int jp = 0; jp < 2; ++jp) { const LAS unsigned char* p = (const LAS unsigned char*)(vv + (32 * jp + 8 * g + (i16 >> 2)) * VP + 16 * mt + 4 * (i16 & 3));
            a = mfma16(cat8(tr16(p), tr16(p + 4 * VP * 2)), Pf[jp], a); }
#pragma unroll
        for (int ks = 0; ks < 2; ++ks) { const float* sp = ST + (16 * mt + i16) * 64 + 32 * ks + 8 * g;
            const f32x4 s0 = *(const GAS f32x4*)sp, s1 = *(const GAS f32x4*)(sp + 4);
            a = mfma16(pack8(s0, s1), Bq[ks], a); }
        acc[mt] = a;
    }
    float ss = 0.f;
#pragma unroll
    for (int mt = 0; mt < 8; ++mt) ss += (acc[mt][0] * acc[mt][0] + acc[mt][1] * acc[mt][1]) + (acc[mt][2] * acc[mt][2] + acc[mt][3] * acc[mt][3]);
    ss += __shfl_xor(ss, 16); ss += __shfl_xor(ss, 32);
    const float rstd = 1.f / sqrtf(ss * (1.f / 128.f) + EPS);
    const size_t trow = row0 + itok;
    bf16* MIX = WSP(bf16, WS_XN);
#pragma unroll
    for (int mt = 0; mt < 8; ++mt) { const int e0 = 16 * mt + 4 * g;
        const f32x4 gg = *(const GAS f32x4*)(FIN(9) + e0);
        const v2u gw2 = *(const GAS v2u*)(PROJ + trow * NPROJ + C_GR + h * 128 + e0);
        float gr[4] = {bflo(gw2.x), bfhi(gw2.x), bflo(gw2.y), bfhi(gw2.y)}; float o[4];
#pragma unroll
        for (int r = 0; r < 4; ++r) o[r] = acc[mt][r] * rstd * gg[r] * (gr[r] / (1.f + __expf(-gr[r])));
        v2u w; w.x = pk2(o[0], o[1]); w.y = pk2(o[2], o[3]);
        *(GAS v2u*)(MIX + trow * DM + 512 + h * 128 + e0) = w; }
    __syncthreads();
}

constexpr int AT_BIAS = 0, AT_VST = 16384, BIAS_LD = 132;
template <int D>
__device__ __forceinline__ void attn_pattern(const bf16* Kb, const bf16* Vb, int tq0, const LAS float* bias, LAS unsigned char* vst,
                                             const bf16x8 (&qf)[2], float& Mrun, float& Lrun, f32x4 (&O)[4], int lane, int ns, int kofs) {
    constexpr int QS = 16 / D;
    const int i16 = lane & 15, g = lane >> 4;
    const int r = tq0 & (D - 1), lqb = tq0 / D, lq = lqb + QS * i16, lk0 = lqb + QS * 15 - kofs;
    bf16x8 kc[4], kn[4]; v4u vr[4], vn[4];
#define AT_KLOAD(dst, s_) do { const int ka_ = lk0 + 32 * (s_) + 8 * (i16 >> 2) + (i16 & 3), kb_ = ka_ + 4; \
        const int ta_ = (ka_ < 0 ? 0 : ka_) * D + r, tb_ = (kb_ < 0 ? 0 : kb_) * D + r; \
        const bf16* pa_ = Kb + (size_t)ta_ * NPROJ + 8 * g; const bf16* pb_ = Kb + (size_t)tb_ * NPROJ + 8 * g; \
        dst[0] = *(const GAS bf16x8*)pa_; dst[1] = *(const GAS bf16x8*)(pa_ + 32); dst[2] = *(const GAS bf16x8*)pb_; dst[3] = *(const GAS bf16x8*)(pb_ + 32); } while (0)
#define AT_VLOAD(dst, s_) do { _Pragma("unroll") for (int ii = 0; ii < 4; ++ii) { int lk_ = lk0 + 32 * (s_) + 8 * ii + (lane >> 3); lk_ = lk_ < 0 ? 0 : lk_; \
        dst[ii] = *(const GAS v4u*)(Vb + (size_t)(lk_ * D + r) * NPROJ + (lane & 7) * 8); } } while (0)
    AT_KLOAD(kc, 0); AT_VLOAD(vr, 0);
#pragma unroll 1
    for (int s = 0; s < ns; ++s) {
        const int sn = (s + 1 < ns) ? s + 1 : s;
        AT_KLOAD(kn, sn); AT_VLOAD(vn, sn);
        const f32x4 z = {0.f, 0.f, 0.f, 0.f};
        f32x4 sa = mfma16(kc[1], qf[1], mfma16(kc[0], qf[0], z));
        f32x4 sb = mfma16(kc[3], qf[1], mfma16(kc[2], qf[0], z));
        float mx = -1e30f;
#pragma unroll
        for (int e = 0; e < 4; ++e) {
            { const int lk = lk0 + 32 * s + 8 * g + e, rel = lq - lk; const bool ok = (rel >= 0) & (rel <= 128) & (lk >= 0);
              const float bv = bias[min(max(rel, 0), 128)]; const float v = (sa[e] + bv) + (ok ? 0.f : -1e30f); sa[e] = v; mx = fmaxf(mx, v); }
            { const int lk = lk0 + 32 * s + 8 * g + 4 + e, rel = lq - lk; const bool ok = (rel >= 0) & (rel <= 128) & (lk >= 0);
              const float bv = bias[min(max(rel, 0), 128)]; const float v = (sb[e] + bv) + (ok ? 0.f : -1e30f); sb[e] = v; mx = fmaxf(mx, v); }
        }
        mx = fmaxf(mx, __shfl_xor(mx, 16)); mx = fmaxf(mx, __shfl_xor(mx, 32));
        const float Mnew = fmaxf(Mrun, mx), alpha = __builtin_amdgcn_exp2f(Mrun - Mnew);
        Mrun = Mnew;
        float ls = 0.f;
#pragma unroll
        for (int e = 0; e < 4; ++e) { sa[e] = __builtin_amdgcn_exp2f(sa[e] - Mnew); sb[e] = __builtin_amdgcn_exp2f(sb[e] - Mnew); ls += sa[e] + sb[e]; }
        Lrun = Lrun * alpha + ls;
        const bf16x8 pf = pack8(sa, sb);
#pragma unroll
        for (int ii = 0; ii < 4; ++ii) *(LAS v4u*)(vst + (8 * ii + (lane >> 3)) * 128 + (lane & 7) * 16) = vr[ii];
#pragma unroll
        for (int mt = 0; mt < 4; ++mt) { const LAS unsigned char* p = vst + (8 * g + (i16 >> 2)) * 128 + (16 * mt + 4 * (i16 & 3)) * 2;
            O[mt] = mfma16(cat8(tr16(p), tr16(p + 512)), pf, O[mt] * alpha); }
#pragma unroll
        for (int q = 0; q < 4; ++q) { kc[q] = kn[q]; vr[q] = vn[q]; }
    }
#undef AT_KLOAD
#undef AT_VLOAD
}
__device__ __forceinline__ void attn_item(Frame& F, int it, LAS unsigned char* vst, const LAS float* biasT, int lane) {
    const int rho = it & 15, tile = (it >> 4) & 31, h = (it >> 9) & 7, b = it >> 12;
    const int tq0 = tile * 256 + rho, i16 = lane & 15, g = lane >> 4;
    const bf16* PROJ = WSP(bf16, WS_PROJ) + (size_t)b * SEQ * NPROJ;
    const bf16* qp = PROJ + (size_t)(tq0 + 16 * i16) * NPROJ + C_AQ + h * 64 + 8 * g;
    bf16x8 qf[2]; qf[0] = *(const GAS bf16x8*)qp; qf[1] = *(const GAS bf16x8*)(qp + 32);
    float Mrun = -1e30f, Lrun = 0.f; f32x4 O[4];
#pragma unroll
    for (int mt = 0; mt < 4; ++mt) O[mt] = (f32x4){0.f, 0.f, 0.f, 0.f};
    const bf16* Kb = PROJ + C_AK + h * 64; const bf16* Vb = PROJ + C_AV + h * 64;
    attn_pattern<1>(Kb, Vb, tq0, biasT + (0 * 8 + h) * BIAS_LD, vst, qf, Mrun, Lrun, O, lane, 12, 383);
    attn_pattern<4>(Kb, Vb, tq0, biasT + (1 * 8 + h) * BIAS_LD, vst, qf, Mrun, Lrun, O, lane, 6, 191);
    attn_pattern<16>(Kb, Vb, tq0, biasT + (2 * 8 + h) * BIAS_LD, vst, qf, Mrun, Lrun, O, lane, 5, 159);
    float L = Lrun; L += __shfl_xor(L, 16); L += __shfl_xor(L, 32);
    const float inv = 1.f / L;
    bf16* MIX = WSP(bf16, WS_XN) + ((size_t)b * SEQ + tq0 + 16 * i16) * DM + h * 64;
#pragma unroll
    for (int mt = 0; mt < 4; ++mt) { v2u w; w.x = pk2(O[mt][0] * inv, O[mt][1] * inv); w.y = pk2(O[mt][2] * inv, O[mt][3] * inv); *(GAS v2u*)(MIX + 16 * mt + 4 * g) = w; }
}
__device__ __forceinline__ int t5_bucket(int dist) {
    if (dist < 16) return dist;
    return 16 + (dist >= 22) + (dist >= 30) + (dist >= 40) + (dist >= 54) + (dist >= 73) + (dist >= 99) + (dist >= 134) + (dist >= 182) + (dist >= 246)
              + (dist >= 332) + (dist >= 450) + (dist >= 609) + (dist >= 825) + (dist >= 1117) + (dist >= 1513);
}
__device__ __forceinline__ void p3_attn_and_gla_prep(Frame& F) {
#ifndef NO_GLAPREP
    { const int half = F.wave >> 2, tl = F.tid & 255, wl = F.wave & 3; LAS unsigned char* L = F.lds + RING_OFF + half * GL_HALF;
      const int nh = F.G * 2;
      for (int base = 0; base < 1024; base += nh) { int item = base + F.vcu * 2 + half; item = item > 1023 ? 1023 : item; gla_prep_item(F, item, L, tl, wl, F.lane); }
    }
#endif
    __syncthreads();
    LAS float* biasT = (LAS float*)(F.lds + RING_OFF + AT_BIAS);
    for (int idx = F.tid; idx < 3 * 8 * 129; idx += NWAVES * 64) { const int p = idx / (8 * 129), rem = idx % (8 * 129), h = rem / 129, rel = rem % 129;
        const int dil = p == 0 ? 1 : (p == 1 ? 4 : 16);
        biasT[(p * 8 + h) * BIAS_LD + rel] = FIN(10)[t5_bucket(rel * dil) * 8 + h] * LOG2E; }
    __syncthreads();
    LAS unsigned char* vst = F.lds + RING_OFF + AT_VST + F.wave * 4096;
    const int gw = F.vcu * NWAVES + F.wave, NGW = F.G * NWAVES;
#ifndef NO_ATTN
    for (int it = gw; it < 2 * 8 * 32 * 16; it += NGW) attn_item(F, it, vst, biasT, F.lane);
#endif
}
__device__ __forceinline__ void p5_gla_out(Frame& F) {
    const int half = F.wave >> 2, tl = F.tid & 255, wl = F.wave & 3; LAS unsigned char* L = F.lds + RING_OFF + half * GL_HALF5;
    const int nh = F.G * 2;
    for (int base = 0; base < 1024; base += nh) { int item = base + F.vcu * 2 + half; item = item > 1023 ? 1023 : item; gla_out_item(F, item, L, tl, wl, F.lane); }
}
__device__ __forceinline__ void p7_postmix(Frame& F) {
    const int gw = F.vcu * NWAVES + F.wave, NGW = F.G * NWAVES, lane = F.lane;
    const float* MOD = (const float*)(F.ctl + CW_MOD); const float* Y1 = WSP(float, WS_PROJ); bf16* XN = WSP(bf16, WS_XN);
    for (int m = gw; m < M; m += NGW) {
        const int b = m >> 13;
        const GAS f32x4* yr = (const GAS f32x4*)(Y1 + (size_t)m * DM) + lane; const GAS f32x4* xr = (const GAS f32x4*)(FIN(0) + (size_t)m * DM) + lane;
        f32x4 y[4], xv[4]; float s = 0.f;
#pragma unroll
        for (int j = 0; j < 4; ++j) { y[j] = yr[64 * j]; xv[j] = xr[64 * j]; s += (y[j].x * y[j].x + y[j].y * y[j].y) + (y[j].z * y[j].z + y[j].w * y[j].w); }
        const float rstd = 1.f / sqrtf(wave_sum(s) * (1.f / DM) + EPS);
        float s1 = 0.f;
        GAS f32x4* orow = (GAS f32x4*)(F.A->out + (size_t)m * DM) + lane;
#pragma unroll
        for (int j = 0; j < 4; ++j) { const int col = 256 * j + 4 * lane;
            const f32x4 gp = *(const GAS f32x4*)(FIN(5) + col), ga = *(const GAS f32x4*)(MOD + b * MOD_LD + MOD_GA1 + col);
            xv[j] = xv[j] + ga * (y[j] * rstd * gp); orow[64 * j] = xv[j];
            s1 += (xv[j].x * xv[j].x + xv[j].y * xv[j].y) + (xv[j].z * xv[j].z + xv[j].w * xv[j].w); }
        const float rstd1 = 1.f / sqrtf(wave_sum(s1) * (1.f / DM) + EPS);
        GAS v2u* o8 = (GAS v2u*)(XN + (size_t)m * DM) + lane;
#pragma unroll
        for (int j = 0; j < 4; ++j) { const int col = 256 * j + 4 * lane;
            const f32x4 g = *(const GAS f32x4*)(FIN(12) + col), sc = *(const GAS f32x4*)(MOD + b * MOD_LD + MOD_SC2 + col), sh = *(const GAS f32x4*)(MOD + b * MOD_LD + MOD_SH2 + col);
            const f32x4 h = xv[j] * rstd1 * g * (sc + 1.f) + sh;
            v2u w; w.x = pk2(h.x, h.y); w.y = pk2(h.z, h.w); o8[64 * j] = w; }
    }
}

__device__ __forceinline__ unsigned umax_(unsigned a, unsigned b) { return a > b ? a : b; }
__device__ __forceinline__ unsigned umin_(unsigned a, unsigned b) { return a < b ? a : b; }
template <int N> __device__ __forceinline__ void bitonic_sort_desc(unsigned (&x)[N]) {
#pragma unroll
    for (int k = 2; k <= N; k <<= 1)
#pragma unroll
        for (int j = k >> 1; j > 0; j >>= 1)
#pragma unroll
            for (int i = 0; i < N; ++i) { const int l = i ^ j; if (l > i) { const unsigned a = x[i], b = x[l]; const bool desc = ((i & k) == 0);
                x[i] = desc ? umax_(a, b) : umin_(a, b); x[l] = desc ? umin_(a, b) : umax_(a, b); } }
}
__device__ __forceinline__ void merge16(unsigned (&a)[16], const unsigned (&b)[16]) {
#pragma unroll
    for (int i = 0; i < 16; ++i) a[i] = umax_(a[i], b[15 - i]);
#pragma unroll
    for (int j = 8; j > 0; j >>= 1)
#pragma unroll
        for (int i = 0; i < 16; ++i) { const int l = i ^ j; if (l > i) { const unsigned hi = umax_(a[i], a[l]), lo = umin_(a[i], a[l]); a[i] = hi; a[l] = lo; } }
}
__device__ __forceinline__ void p9_item(Frame& F, int it, int lane) {
    const int head = it & 7, tile = it >> 3, i16 = lane & 15, g = lane >> 4, tok = tile * 16 + i16;
    const bf16* Q = WSP(bf16, WS_PROJ) + (size_t)tok * PQD + head * 256;
    const bf16* SK = WSP(bf16, WS_SUBK) + (size_t)head * 2 * 128 * 128;
    unsigned top[2][16];
#pragma unroll
    for (int p = 0; p < 2; ++p) {
        bf16x8 Bq[4];
#pragma unroll
        for (int ks = 0; ks < 4; ++ks) Bq[ks] = *(const GAS bf16x8*)(Q + p * 128 + 32 * ks + 8 * g);
        unsigned lo[16], hi[16];
#pragma unroll
        for (int kt = 0; kt < 8; ++kt) {
            f32x4 acc = {0.f, 0.f, 0.f, 0.f};
            const bf16* ap = SK + (size_t)(p * 128 + 16 * kt + i16) * 128 + 8 * g;
#pragma unroll
            for (int ks = 0; ks < 4; ++ks) acc = mfma16(*(const GAS bf16x8*)(ap + 32 * ks), Bq[ks], acc);
#pragma unroll
            for (int r = 0; r < 4; ++r) { const int key = 16 * kt + 4 * g + r; float f = (acc[r] + 16.f) * 1048576.f; f = fminf(fmaxf(f, 0.f), 33554431.f);
                const unsigned pk = ((unsigned)f << 7) | (unsigned)(127 - key);
                if (kt < 4) lo[4 * kt + r] = pk; else hi[4 * (kt - 4) + r] = pk; }
        }
        bitonic_sort_desc<16>(lo); bitonic_sort_desc<16>(hi); merge16(lo, hi);
#pragma unroll
        for (int xr = 16; xr <= 32; xr <<= 1) {
#pragma unroll
            for (int i = 0; i < 16; ++i) hi[i] = (unsigned)__shfl_xor((int)lo[i], xr);
            merge16(lo, hi); }
#pragma unroll
        for (int i = 0; i < 16; ++i) top[p][i] = lo[i];
    }
    unsigned c[4][16];
#pragma unroll
    for (int q = 0; q < 4; ++q)
#pragma unroll
        for (int i = 0; i < 16; ++i) c[q][i] = 0u;
    {
        int n = 0;
#pragma unroll
        for (int i = 0; i < 16; ++i)
#pragma unroll
            for (int j = 0; j < 16; ++j) if ((i + 1) * (j + 1) <= 16) {
                const unsigned A = top[0][i], B = top[1][j];
                const unsigned ex = (127u - (A & 127u)) * 128u + (127u - (B & 127u));
                c[n >> 4][n & 15] = ((((A >> 7) + (B >> 7)) >> 8) << 14) | ex; ++n; }
    }
    bitonic_sort_desc<16>(c[0]); bitonic_sort_desc<16>(c[1]); bitonic_sort_desc<16>(c[2]); bitonic_sort_desc<16>(c[3]);
    merge16(c[0], c[1]); merge16(c[2], c[3]); merge16(c[0], c[2]);
    float ev[16]; float sum = 0.f;
    const float f0 = (float)(c[0][0] >> 14);
#pragma unroll
    for (int k = 0; k < 16; ++k) { ev[k] = __expf(((float)(c[0][k] >> 14) - f0) * (1.f / 4096.f)); sum += ev[k]; }
    const float inv = 1.f / sum;
    int* EIDX = WSP(int, WS_EIDX) + (size_t)tok * 128 + head * 16; float* GATE = WSP(float, WS_GATE) + (size_t)tok * 128 + head * 16;
#pragma unroll
    for (int k = 0; k < 16; ++k) if (g == (k >> 2)) { EIDX[k] = (int)(c[0][k] & 16383u); GATE[k] = ev[k] * inv; }
}
__device__ __forceinline__ void p9_topk(Frame& F) {
    const int gw = F.vcu * NWAVES + F.wave, NGW = F.G * NWAVES;
    for (int it = gw; it < (M / 16) * 8; it += NGW) p9_item(F, it, F.lane);
}

__device__ __forceinline__ float gelu_erf(float s) { return 0.5f * s * (1.f + erff(s * 0.70710678118654752f)); }
__device__ __forceinline__ float xreduce16(float (&v)[16], int c) {
    float w8[8], w4[4], w2[2];
    const bool b3 = (c & 8) != 0, b2 = (c & 4) != 0, b1 = (c & 2) != 0, b0 = (c & 1) != 0;
#pragma unroll
    for (int i = 0; i < 8; ++i) { const float keep = b3 ? v[i + 8] : v[i], give = b3 ? v[i] : v[i + 8]; w8[i] = keep + __shfl_xor(give, 8); }
#pragma unroll
    for (int i = 0; i < 4; ++i) { const float keep = b2 ? w8[i + 4] : w8[i], give = b2 ? w8[i] : w8[i + 4]; w4[i] = keep + __shfl_xor(give, 4); }
#pragma unroll
    for (int i = 0; i < 2; ++i) { const float keep = b1 ? w4[i + 2] : w4[i], give = b1 ? w4[i] : w4[i + 2]; w2[i] = keep + __shfl_xor(give, 2); }
    const float keep = b0 ? w2[1] : w2[0], give = b0 ? w2[0] : w2[1];
    return keep + __shfl_xor(give, 1);
}
#if PEER_FP8
__device__ __forceinline__ float xreduce8(float (&v)[8], int c) {
    float w4[4], w2[2];
    const bool b2 = (c & 4) != 0, b1 = (c & 2) != 0, b0 = (c & 1) != 0;
#pragma unroll
    for (int i = 0; i < 4; ++i) { const float keep = b2 ? v[i + 4] : v[i], give = b2 ? v[i] : v[i + 4]; w4[i] = keep + __shfl_xor(give, 4); }
#pragma unroll
    for (int i = 0; i < 2; ++i) { const float keep = b1 ? w4[i + 2] : w4[i], give = b1 ? w4[i] : w4[i + 2]; w2[i] = keep + __shfl_xor(give, 2); }
    const float keep = b0 ? w2[1] : w2[0], give = b0 ? w2[0] : w2[1];
    return keep + __shfl_xor(give, 1);
}
__device__ __forceinline__ void p10_peer_u(Frame& F) {
    const int lane = F.lane, r = lane >> 3, c = lane & 7;
    const int sl = (int)blockIdx.x & 7, rank = (int)blockIdx.x >> 3, nrank = F.G >> 3;
    const bf16* XN = WSP(bf16, WS_XN) + 128 * sl + 16 * c; const unsigned char* US = WSP(unsigned char, WS_U16) + (size_t)sl * NEXP * 128 + 16 * c;
    const int* EIDX = WSP(int, WS_EIDX); float* PART = WSP(float, WS_PART) + sl * 128;
    const int st = nrank * NWAVES, t0 = rank * NWAVES + F.wave;
    if (t0 >= M) return;
#define P10_IDX(t_, ea, eb, ha, hb) do { const int tt_ = (t_) < M ? (t_) : M - 1; ea = EIDX[(size_t)tt_ * 128 + lane]; eb = EIDX[(size_t)tt_ * 128 + 64 + lane]; \
        ha = *(const GAS v4u*)(XN + (size_t)tt_ * DM); hb = *(const GAS v4u*)(XN + (size_t)tt_ * DM + 8); } while (0)
#define P10_GATHER(G, ee) do { _Pragma("unroll") for (int j_ = 0; j_ < 8; ++j_) G[j_] = *(const GAS v4u*)(US + (size_t)__shfl(ee, 8 * j_ + r) * 128); } while (0)
#define P10_HALF(G, hf_) do { float pv[8]; \
        _Pragma("unroll") for (int j = 0; j < 8; ++j) { const v4u a = G[j]; float s0 = 0.f, s1 = 0.f; \
            _Pragma("unroll") for (int q = 0; q < 4; ++q) { const f32x2 lo = __builtin_amdgcn_cvt_pk_f32_fp8((int)a[q], false), hi = __builtin_amdgcn_cvt_pk_f32_fp8((int)a[q], true); \
                s0 += lo.x * h[4 * q] + hi.x * h[4 * q + 2]; s1 += lo.y * h[4 * q + 1] + hi.y * h[4 * q + 3]; } \
            pv[j] = s0 + s1; } \
        const float tot = xreduce8(pv, c); PART[(size_t)tA * 1024 + 64 * (hf_) + 8 * c + r] = tot * (1.f / 512.f); } while (0)
    int tA = t0;
    int eA0, eA1, eB0, eB1; v4u hA0, hA1, hB0, hB1; v4u G0[8], G1[8];
    P10_IDX(tA, eA0, eA1, hA0, hA1);
    P10_GATHER(G0, eA0);
#pragma unroll 1
    for (; tA < M; ) {
        const int tB = tA + st;
        P10_IDX(tB, eB0, eB1, hB0, hB1);
        P10_GATHER(G1, eA1);
        float h[16];
#pragma unroll
        for (int q = 0; q < 4; ++q) { h[2 * q] = bflo(hA0[q]); h[2 * q + 1] = bfhi(hA0[q]); h[8 + 2 * q] = bflo(hA1[q]); h[8 + 2 * q + 1] = bfhi(hA1[q]); }
        P10_HALF(G0, 0);
        P10_GATHER(G0, eB0);
        P10_HALF(G1, 1);
        eA0 = eB0; eA1 = eB1; hA0 = hB0; hA1 = hB1; tA = tB;
    }
#undef P10_IDX
#undef P10_GATHER
#undef P10_HALF
}
__device__ __forceinline__ void p11_peer_v(Frame& F) {
    const int lane = F.lane, r = lane >> 3, c = lane & 7;
    const int sl = (int)blockIdx.x & 7, rank = (int)blockIdx.x >> 3, nrank = F.G >> 3;
    const unsigned char* VS = WSP(unsigned char, WS_V16) + (size_t)sl * NEXP * 128 + 16 * c;
    const int* EIDX = WSP(int, WS_EIDX); const float* GATE = WSP(float, WS_GATE); const float* PART = WSP(float, WS_PART); float* Y2 = WSP(float, WS_Y2);
    const bool b5 = (lane & 32) != 0, b4 = (lane & 16) != 0, b3 = (lane & 8) != 0;
    const int st = nrank * NWAVES, t0 = rank * NWAVES + F.wave;
    if (t0 >= M) return;
#define P11_IDX(t_, ea, eb) do { const int tt_ = (t_) < M ? (t_) : M - 1; ea = EIDX[(size_t)tt_ * 128 + lane]; eb = EIDX[(size_t)tt_ * 128 + 64 + lane]; } while (0)
#define P11_RAW(t_, ra, rb, ga, gb) do { const int tt_ = (t_) < M ? (t_) : M - 1; ra = 0.f; rb = 0.f; \
        _Pragma("unroll") for (int q_ = 0; q_ < 8; ++q_) { ra += PART[(size_t)tt_ * 1024 + q_ * 128 + lane]; rb += PART[(size_t)tt_ * 1024 + q_ * 128 + 64 + lane]; } \
        ga = GATE[(size_t)tt_ * 128 + lane]; gb = GATE[(size_t)tt_ * 128 + 64 + lane]; } while (0)
#define P11_GATHER(G, ee) do { _Pragma("unroll") for (int j_ = 0; j_ < 8; ++j_) G[j_] = *(const GAS v4u*)(VS + (size_t)__shfl(ee, 8 * j_ + r) * 128); } while (0)
#define P11_HALF(G, ww) do { _Pragma("unroll") for (int j = 0; j < 8; ++j) { const float w = __shfl(ww, 8 * j + r); const v4u a = G[j]; \
            _Pragma("unroll") for (int q = 0; q < 4; ++q) { const f32x2 lo = __builtin_amdgcn_cvt_pk_f32_fp8((int)a[q], false), hi = __builtin_amdgcn_cvt_pk_f32_fp8((int)a[q], true); \
                acc[4 * q] += w * lo.x; acc[4 * q + 1] += w * lo.y; acc[4 * q + 2] += w * hi.x; acc[4 * q + 3] += w * hi.y; } } } while (0)
    int tA = t0;
    int eA0, eA1, eB0, eB1; float rA0, rA1, gA0, gA1, rB0, rB1, gB0, gB1; v4u G0[8], G1[8];
    P11_IDX(tA, eA0, eA1);
    P11_RAW(tA, rA0, rA1, gA0, gA1);
    P11_GATHER(G0, eA0);
#pragma unroll 1
    for (; tA < M; ) {
        const int tB = tA + st;
        P11_IDX(tB, eB0, eB1);
        P11_GATHER(G1, eA1);
        const float w0 = gA0 * gelu_erf(rA0) * (1.f / 512.f), w1 = gA1 * gelu_erf(rA1) * (1.f / 512.f);
        float acc[16];
#pragma unroll
        for (int i = 0; i < 16; ++i) acc[i] = 0.f;
        P11_HALF(G0, w0);
        asm volatile("" ::: "memory");
        P11_RAW(tB, rB0, rB1, gB0, gB1);
        P11_GATHER(G0, eB0);
        asm volatile("" ::: "memory");
        P11_HALF(G1, w1);
        float w8[8], w4[4], w2[2];
#pragma unroll
        for (int i = 0; i < 8; ++i) { const float keep = b5 ? acc[i + 8] : acc[i], give = b5 ? acc[i] : acc[i + 8]; w8[i] = keep + __shfl_xor(give, 32); }
#pragma unroll
        for (int i = 0; i < 4; ++i) { const float keep = b4 ? w8[i + 4] : w8[i], give = b4 ? w8[i] : w8[i + 4]; w4[i] = keep + __shfl_xor(give, 16); }
#pragma unroll
        for (int i = 0; i < 2; ++i) { const float keep = b3 ? w4[i + 2] : w4[i], give = b3 ? w4[i] : w4[i + 2]; w2[i] = keep + __shfl_xor(give, 8); }
        *(GAS f32x2*)(Y2 + (size_t)tA * DM + 128 * sl + 16 * c + (b5 ? 8 : 0) + (b4 ? 4 : 0) + (b3 ? 2 : 0)) = (f32x2){w2[0], w2[1]};
        eA0 = eB0; eA1 = eB1; rA0 = rB0; rA1 = rB1; gA0 = gB0; gA1 = gB1; tA = tB;
    }
#undef P11_IDX
#undef P11_RAW
#undef P11_GATHER
#undef P11_HALF
}
#else
__device__ __forceinline__ void p10_peer_u(Frame& F) {
    const int lane = F.lane, r = lane >> 4, c = lane & 15;
    const int sl = (int)blockIdx.x & 7, rank = (int)blockIdx.x >> 3, nrank = F.G >> 3;
    const bf16* XN = WSP(bf16, WS_XN); const bf16* US = WSP(bf16, WS_U16) + (size_t)sl * NEXP * 128 + 8 * c;
    const int* EIDX = WSP(int, WS_EIDX); float* PART = WSP(float, WS_PART) + sl * 128;
    for (int tok = rank * NWAVES + F.wave; tok < M; tok += nrank * NWAVES) {
        const v4u hq = *(const GAS v4u*)(XN + (size_t)tok * DM + 128 * sl + 8 * c);
        const int e0 = EIDX[(size_t)tok * 128 + lane], e1 = EIDX[(size_t)tok * 128 + 64 + lane];
#pragma unroll
        for (int hf = 0; hf < 2; ++hf) {
            float pv[16];
#pragma unroll
            for (int j = 0; j < 16; ++j) {
                const int e = __shfl(hf == 0 ? e0 : e1, 4 * j + r);
                const v4u a = *(const GAS v4u*)(US + (size_t)e * 128);
                pv[j] = dot2bf(a.w, hq.w, dot2bf(a.z, hq.z, dot2bf(a.y, hq.y, dot2bf(a.x, hq.x, 0.f))));
            }
            const float tot = xreduce16(pv, c);
            PART[(size_t)tok * 1024 + 64 * hf + 4 * c + r] = tot;
        }
    }
}
__device__ __forceinline__ void p11_peer_v(Frame& F) {
    const int lane = F.lane, r = lane >> 4, c = lane & 15;
    const int sl = (int)blockIdx.x & 7, rank = (int)blockIdx.x >> 3, nrank = F.G >> 3;
    const bf16* VS = WSP(bf16, WS_V16) + (size_t)sl * NEXP * 128 + 8 * c;
    const int* EIDX = WSP(int, WS_EIDX); const float* GATE = WSP(float, WS_GATE); const float* PART = WSP(float, WS_PART); float* Y2 = WSP(float, WS_Y2);
    for (int tok = rank * NWAVES + F.wave; tok < M; tok += nrank * NWAVES) {
        const int e0 = EIDX[(size_t)tok * 128 + lane], e1 = EIDX[(size_t)tok * 128 + 64 + lane];
        float a0 = 0.f, a1 = 0.f;
#pragma unroll
        for (int q = 0; q < 8; ++q) { a0 += PART[(size_t)tok * 1024 + q * 128 + lane]; a1 += PART[(size_t)tok * 1024 + q * 128 + 64 + lane]; }
        const float w0 = GATE[(size_t)tok * 128 + lane] * gelu_erf(a0), w1 = GATE[(size_t)tok * 128 + 64 + lane] * gelu_erf(a1);
        float acc[8];
#pragma unroll
        for (int i = 0; i < 8; ++i) acc[i] = 0.f;
#pragma unroll
        for (int hf = 0; hf < 2; ++hf)
#pragma unroll 8
            for (int j = 0; j < 16; ++j) {
                const int e = __shfl(hf == 0 ? e0 : e1, 4 * j + r); const float w = __shfl(hf == 0 ? w0 : w1, 4 * j + r);
                const v4u a = *(const GAS v4u*)(VS + (size_t)e * 128);
#pragma unroll
                for (int i = 0; i < 4; ++i) { acc[2 * i] += w * bflo(a[i]); acc[2 * i + 1] += w * bfhi(a[i]); }
            }
#pragma unroll
        for (int i = 0; i < 8; ++i) { acc[i] += __shfl_xor(acc[i], 16); acc[i] += __shfl_xor(acc[i], 32); }
        if (r == 0) { float* yp = Y2 + (size_t)tok * DM + 128 * sl + 8 * c;
            *(GAS f32x4*)yp = (f32x4){acc[0], acc[1], acc[2], acc[3]}; *(GAS f32x4*)(yp + 4) = (f32x4){acc[4], acc[5], acc[6], acc[7]}; }
    }
}
#endif
__device__ __forceinline__ void p12_final(Frame& F) {
    const int gw = F.vcu * NWAVES + F.wave, NGW = F.G * NWAVES, lane = F.lane;
    const float* MOD = (const float*)(F.ctl + CW_MOD); const float* Y2 = WSP(float, WS_Y2);
    for (int m = gw; m < M; m += NGW) {
        const int b = m >> 13;
        const GAS f32x4* yr = (const GAS f32x4*)(Y2 + (size_t)m * DM) + lane; GAS f32x4* orow = (GAS f32x4*)(F.A->out + (size_t)m * DM) + lane;
        f32x4 y[4], xv[4]; float s = 0.f;
#pragma unroll
        for (int j = 0; j < 4; ++j) { y[j] = yr[64 * j]; xv[j] = orow[64 * j]; s += (y[j].x * y[j].x + y[j].y * y[j].y) + (y[j].z * y[j].z + y[j].w * y[j].w); }
        const float rstd = 1.f / sqrtf(wave_sum(s) * (1.f / DM) + EPS);
#pragma unroll
        for (int j = 0; j < 4; ++j) { const int col = 256 * j + 4 * lane;
            const f32x4 gp = *(const GAS f32x4*)(FIN(13) + col), ga = *(const GAS f32x4*)(MOD + b * MOD_LD + MOD_GA2 + col);
            orow[64 * j] = xv[j] + ga * (y[j] * rstd * gp); }
    }
}

__global__ void __launch_bounds__(NWAVES * 64, 2) hyb_fwd(Args args) {
    extern __shared__ __attribute__((aligned(16))) unsigned char lds[];
    Frame F;
    F.lds = (LAS unsigned char*)lds;
    F.MISC = (volatile LAS unsigned*)(F.lds + MISC_OFF);
    F.tid = threadIdx.x; F.lane = F.tid & 63; F.wave = __builtin_amdgcn_readfirstlane(F.tid >> 6);
    F.G = gridDim.x; { const int bx = blockIdx.x; F.vcu = (F.G % 8 == 0) ? (bx % 8) * (F.G / 8) + bx / 8 : bx; }
    F.ctl = (gu32*)(args.ws + WS_CTL);
    F.A = (const __attribute__((address_space(4))) struct Args*)__builtin_amdgcn_kernarg_segment_ptr();
    for (int u = F.tid; u < (LDS_BYTES - LDSCTL_OFF) / 4; u += NWAVES * 64) ((LAS unsigned*)(F.lds + LDSCTL_OFF))[u] = 0u;
    __syncthreads();
    const int lo = args.ph_lo, hi = args.ph_hi;
    const bool one = (hi - lo) > 1;
    XcdBarrier bar; bar.bar = (unsigned*)(F.ctl + CW_BAR); bar.x = 0; bar.st = nullptr;
    if (one) bar = xcd_barrier_post((unsigned*)(F.ctl + CW_BAR), F.MISC + 8, F.wave);
#ifndef PH_MASK
#define PH_MASK 0x1fff
#endif
#define IN(k) (((PH_MASK >> (k)) & 1) && lo <= (k) && (k) < hi && launder(F))
#define SEAM(k) do { if (IN(k) && IN((k) + 1)) xcd_barrier(bar, F.wave); } while (0)
#ifndef REP_MASK
#define REP_MASK 0
#endif
#define REPS(k) (1 + ((REP_MASK >> (k)) & 1))
    if (IN(0)) { for (int rp = 0; rp < REPS(0); ++rp) { p0_prologue(F); SEAM(0); } }
    if (IN(1)) { for (int rp = 0; rp < REPS(1); ++rp) { p1_modulate(F); SEAM(1); } }
    if (IN(2)) for (int rp = 0; rp < REPS(2); ++rp) {
        pg8::Gemm g{WSP(bf16, WS_XN), WSP(bf16, WS_WIN), M, NPROJ, DM}; pg8::StaticOrder S; S.init(M, NPROJ, F.G, (int)blockIdx.x);
        pg8::EpiProj E{WSP(bf16, WS_PROJ), NPROJ, 0, C2, 0.125f};
        pg8::gemm_phase<pg8::EpiProj, pg8::StaticOrder, PG8_ALIGN, PG8_SP2>(F.lds + RING_OFF, g, S, E, F.wave);
        SEAM(2);
    }
    if (IN(3)) { for (int rp = 0; rp < REPS(3); ++rp) { p3_attn_and_gla_prep(F); SEAM(3); } }
    if (IN(4)) { gla_scan(F); SEAM(4); }
    if (IN(5)) { for (int rp = 0; rp < REPS(5); ++rp) { p5_gla_out(F); SEAM(5); } }
    if (IN(6)) for (int rp = 0; rp < REPS(6); ++rp) {
        pg8::Gemm g{WSP(bf16, WS_XN), WSP(bf16, WS_WOUT), M, DM, DM}; pg8::StaticOrder S; S.init(M, DM, F.G, (int)blockIdx.x);
        pg8::EpiF32 E{WSP(float, WS_PROJ), DM};
        pg8::gemm_phase<pg8::EpiF32, pg8::StaticOrder, PG8_ALIGN, PG8_SP2>(F.lds + RING_OFF, g, S, E, F.wave);
        SEAM(6);
    }
    if (IN(7)) { for (int rp = 0; rp < REPS(7); ++rp) { p7_postmix(F); SEAM(7); } }
    if (IN(8)) for (int rp = 0; rp < REPS(8); ++rp) {
        pg8::Gemm g{WSP(bf16, WS_XN), WSP(bf16, WS_WPQ), M, PQD, DM}; pg8::StaticOrder S; S.init(M, PQD, F.G, (int)blockIdx.x);
        pg8::EpiProj E{WSP(bf16, WS_PROJ), PQD, 1, 1.f, 1.f};
        pg8::gemm_phase<pg8::EpiProj, pg8::StaticOrder, PG8_ALIGN, PG8_SP2>(F.lds + RING_OFF, g, S, E, F.wave);
        SEAM(8);
    }
    if (IN(9)) { for (int rp = 0; rp < REPS(9); ++rp) { p9_topk(F); SEAM(9); } }
    if (IN(10)) { for (int rp = 0; rp < REPS(10); ++rp) { p10_peer_u(F); SEAM(10); } }
    if (IN(11)) { for (int rp = 0; rp < REPS(11); ++rp) { p11_peer_v(F); SEAM(11); } }
    if (IN(12)) { p12_final(F); }
#undef IN
#undef SEAM
}

extern "C" void kernel_launch(void* const* d_in, const int* in_sizes, int n_in, void* d_out, int out_size, void* d_ws, size_t ws_size, hipStream_t stream) {
    static int grid = 0;
    if (grid == 0) {
        if (n_in != 18 || in_sizes[0] != M * DM || out_size != M * DM || ws_size < WS_END) { fprintf(stderr, "kernel_launch: unexpected shapes (n_in %d, in0 %d, out %d, ws %zu); nothing launched\n", n_in, n_in > 0 ? in_sizes[0] : -1, out_size, ws_size); grid = -1; return; }
        int dev = 0, cus = 0, per_cu = 0;
        if (hipGetDevice(&dev) != hipSuccess || hipDeviceGetAttribute(&cus, hipDeviceAttributeMultiprocessorCount, dev) != hipSuccess) { grid = -1; return; }
        if (hipFuncSetAttribute((const void*)hyb_fwd, hipFuncAttributeMaxDynamicSharedMemorySize, LDS_BYTES) != hipSuccess) { fprintf(stderr, "kernel_launch: hipFuncSetAttribute failed\n"); grid = -1; return; }
        if (hipOccupancyMaxActiveBlocksPerMultiprocessor(&per_cu, (const void*)hyb_fwd, NWAVES * 64, LDS_BYTES) != hipSuccess || per_cu < 1)
            fprintf(stderr, "kernel_launch: note: occupancy query reports %d workgroups per CU\n", per_cu);
        (void)hipGetLastError();
        grid = cus;
    }
    if (grid < 0) return;
    if (hipMemsetAsync((char*)d_ws + WS_CTL, 0, CTL_ZERO_BYTES, stream) != hipSuccess) { fprintf(stderr, "kernel_launch: hipMemsetAsync failed\n"); return; }
    Args a{};
    for (int i = 0; i < 18; ++i) a.in[i] = (const float*)d_in[i];
    a.out = (float*)d_out; a.ws = (unsigned char*)d_ws;
    const int nl = (MK_N_LAUNCHES == 1) ? 1 : NPHASES;
    for (int li = 0; li < nl; ++li) {
        a.ph_lo = (nl == 1) ? 0 : li; a.ph_hi = (nl == 1) ? NPHASES : li + 1; a.li = li;
        hipLaunchKernelGGL(hyb_fwd, dim3(grid), dim3(NWAVES * 64), LDS_BYTES, stream, a);
        const hipError_t le = hipPeekAtLastError();
        if (le != hipSuccess) { fprintf(stderr, "kernel_launch: launch %d failed: %s\n", li, hipGetErrorName(le)); break; }
    }
}
```
